# Optimizing an MI355X kernel written in HIP

```python
import math
import jax, jax.numpy as jnp
from jax import lax
import numpy as np


D_MODEL = 1024
BATCH = 4
SEQ = 8192
DEPTH = 1

HEAD_DIM = 64
N_HEADS_A = 8
N_HEADS_B = 8
DIL_PATTERNS = ((128, 1), (512, 4), (2048, 16))
BAND_BLOCK = 128
ROT_DIM = HEAD_DIM // 4
ROPE_THETA = 500000.0
NSA_GROUPS = 2
NSA_HPG = N_HEADS_B // NSA_GROUPS
CMP_LEN = 32
CMP_STRIDE = 16
CMP_HIDDEN = 4 * HEAD_DIM
SLC_BLOCK = 64
SLC_TOPK = 16
WIN = 512
Q_CHUNK = 128
D_FF = 2816
CONV_W = 3
ALPHA = (2 * DEPTH) ** 0.25
BETA = (8 * DEPTH) ** -0.25
LN_EPS = 1e-5
NEG = -1e30
MIX_WIDTH = (N_HEADS_A + N_HEADS_B) * HEAD_DIM
IN_SPLITS = (N_HEADS_A * HEAD_DIM,) * 3 + (N_HEADS_B * HEAD_DIM,) + (NSA_GROUPS * HEAD_DIM,) * 6 + (N_HEADS_B * 3,)
IN_WIDTH = sum(IN_SPLITS)

kernel_name = 'hybrid_dilated_nsa_convffn'


def layer_norm(x, g=None, b=None):
    xf = x.astype(jnp.float32)
    mu = jnp.mean(xf, -1, keepdims=True)
    var = jnp.mean(jnp.square(xf - mu), -1, keepdims=True)
    y = (xf - mu) * lax.rsqrt(var + LN_EPS)
    if g is not None:
        y = y * g.astype(jnp.float32) + b.astype(jnp.float32)
    return y.astype(x.dtype)


def partial_rope(t, pos):
    inv = 1.0 / (ROPE_THETA ** (jnp.arange(0, ROT_DIM, 2, dtype=jnp.float32) / ROT_DIM))
    ang = pos.astype(jnp.float32)[:, None] * inv[None, :]
    cos, sin = jnp.cos(ang), jnp.sin(ang)
    half = ROT_DIM // 2
    t1 = t[..., :half].astype(jnp.float32)
    t2 = t[..., half:ROT_DIM].astype(jnp.float32)
    rot = jnp.concatenate([t1 * cos - t2 * sin, t1 * sin + t2 * cos], -1).astype(t.dtype)
    return jnp.concatenate([rot, t[..., ROT_DIM:]], -1)


def masked_exp(s, mask, axis):
    s = jnp.where(mask, s, NEG)
    m = jnp.max(s, axis=axis, keepdims=True)
    p = jnp.where(mask, jnp.exp(s - m), 0.0)
    return p, m, jnp.sum(p, axis=axis, keepdims=True)


def band_attention(q, k, v, reach):
    L, hd = q.shape[-2], q.shape[-1]
    n = -(-L // BAND_BLOCK)
    lead = q.shape[:-2]
    padq = [(0, 0)] * len(lead) + [(0, n * BAND_BLOCK - L), (0, 0)]
    padk = [(0, 0)] * len(lead) + [(BAND_BLOCK, n * BAND_BLOCK - L), (0, 0)]
    qb = jnp.pad(q, padq).reshape(*lead, n, BAND_BLOCK, hd)

    def kv_blocks(t):
        t = jnp.pad(t, padk).reshape(*lead, n + 1, BAND_BLOCK, hd)
        return jnp.concatenate([t[..., :-1, :, :], t[..., 1:, :, :]], axis=-2)

    kb, vb = kv_blocks(k), kv_blocks(v)
    s = jnp.einsum('...nqd,...nkd->...nqk', qb, kb).astype(jnp.float32) * (hd ** -0.5)
    blk = jnp.arange(n)[:, None, None] * BAND_BLOCK
    qpos = blk + jnp.arange(BAND_BLOCK)[None, :, None]
    kpos = blk - BAND_BLOCK + jnp.arange(2 * BAND_BLOCK)[None, None, :]
    dist = qpos - kpos
    mask = (dist >= 0) & (dist <= reach) & (kpos >= 0)
    p, m, den = masked_exp(s, mask, -1)
    o = jnp.einsum('...nqk,...nkd->...nqd', p, vb) / den
    lse = (m + jnp.log(den))[..., 0]
    o = o.reshape(*lead, n * BAND_BLOCK, hd)[..., :L, :]
    lse = lse.reshape(*lead, n * BAND_BLOCK)[..., :L]
    return o, lse


def dilated_attention(q, k, v):
    B, H, S, hd = q.shape
    outs, lses = [], []
    for window, dil in DIL_PATTERNS:
        L = -(-S // dil)

        def by_residue(t):
            t = jnp.pad(t, ((0, 0), (0, 0), (0, L * dil - S), (0, 0)))
            return t.reshape(B, H, L, dil, hd).transpose(0, 1, 3, 2, 4)

        o, lse = band_attention(by_residue(q), by_residue(k), by_residue(v), window // dil)
        outs.append(o.transpose(0, 1, 3, 2, 4).reshape(B, H, L * dil, hd)[:, :, :S])
        lses.append(lse.transpose(0, 1, 3, 2).reshape(B, H, L * dil)[:, :, :S])
    w = jax.nn.softmax(jnp.stack(lses, 0), axis=0)[..., None]
    return jnp.sum(w * jnp.stack(outs, 0), axis=0).astype(q.dtype)


def compress(t, pe, w1, w2):
    B, G, S, hd = t.shape
    n = S // CMP_STRIDE
    r = CMP_LEN // CMP_STRIDE
    chunks = t.reshape(B, G, n, CMP_STRIDE, hd)
    blocks = jnp.concatenate([chunks[:, :, j:n - r + 1 + j] for j in range(r)], axis=3)
    blocks = (blocks + pe).reshape(B, G, n - r + 1, CMP_LEN * hd)
    return jax.nn.gelu(blocks @ w1) @ w2


def nsa_attention(q, kc, vc, ks, vs, kw, vw, gate_logits, pe, w_ck1, w_ck2, w_cv1, w_cv2):
    B, Hb, S, hd = q.shape
    G, HG = NSA_GROUPS, NSA_HPG
    scale = hd ** -0.5
    qg = q.reshape(B, G, HG, S, hd)
    gates = jax.nn.sigmoid(gate_logits.astype(jnp.float32)).reshape(B, S, G, HG, 3).transpose(0, 2, 3, 1, 4)
    kcc = compress(kc, pe, w_ck1, w_ck2)
    vcc = compress(vc, pe, w_cv1, w_cv2)
    NC = kcc.shape[2]
    NS = S // SLC_BLOCK
    topk = min(SLC_TOPK, NS)
    cmp_start = jnp.arange(NC) * CMP_STRIDE
    cmp_end = cmp_start + CMP_LEN - 1
    sel_start = jnp.arange(NS) * SLC_BLOCK
    overlap = jnp.clip(jnp.minimum(cmp_start[:, None] + CMP_LEN, sel_start[None, :] + SLC_BLOCK)
                       - jnp.maximum(cmp_start[:, None], sel_start[None, :]), 0, None).astype(jnp.float32) / CMP_LEN
    ksb = ks.reshape(B, G, NS, SLC_BLOCK, hd)
    vsb = vs.reshape(B, G, NS, SLC_BLOCK, hd)
    kw_pad = jnp.pad(kw, ((0, 0), (0, 0), (WIN, 0), (0, 0)))
    vw_pad = jnp.pad(vw, ((0, 0), (0, 0), (WIN, 0), (0, 0)))
    bi = jnp.arange(B)[:, None, None, None]
    gi = jnp.arange(G)[None, :, None, None]
    blk_ids = jnp.arange(NS)
    win_off = jnp.arange(Q_CHUNK + WIN) - WIN

    def chunk(c0):
        t = c0 + jnp.arange(Q_CHUNK)
        qc = lax.dynamic_slice_in_dim(qg, c0, Q_CHUNK, axis=3)
        gc = lax.dynamic_slice_in_dim(gates, c0, Q_CHUNK, axis=3)
        s = jnp.einsum('bghqd,bgnd->bghqn', qc, kcc).astype(jnp.float32) * scale
        p, _, den = masked_exp(s, cmp_end[None, :] <= t[:, None], -1)
        p = p / jnp.where(den > 0, den, 1.0)
        o_cmp = jnp.einsum('bghqn,bgnd->bghqd', p, vcc)
        imp = jnp.einsum('bghqn,ns->bgqs', p, overlap)
        cur = (t // SLC_BLOCK)[:, None]
        forced = (blk_ids[None] == cur) | (blk_ids[None] == cur - 1) | (blk_ids[None] == 0)
        valid = blk_ids[None] * SLC_BLOCK <= t[:, None]
        score = jnp.where(forced, 1e9, jnp.where(valid, imp, -1e9))
        _, idx = lax.top_k(score, topk)
        kg = ksb[bi, gi, idx]
        vg = vsb[bi, gi, idx]
        kpos = idx[..., None] * SLC_BLOCK + jnp.arange(SLC_BLOCK)
        smask = (kpos <= t[None, None, :, None, None])[:, :, None]
        s = jnp.einsum('bghqd,bgqkld->bghqkl', qc, kg).astype(jnp.float32) * scale
        p, _, den = masked_exp(s, smask, (-2, -1))
        o_slc = jnp.einsum('bghqkl,bgqkld->bghqd', p, vg) / den[..., 0]
        kwc = lax.dynamic_slice_in_dim(kw_pad, c0, Q_CHUNK + WIN, axis=2)
        vwc = lax.dynamic_slice_in_dim(vw_pad, c0, Q_CHUNK + WIN, axis=2)
        kpos_w = c0 + win_off
        dist = t[:, None] - kpos_w[None, :]
        wmask = (dist >= 0) & (dist < WIN) & (kpos_w[None, :] >= 0)
        s = jnp.einsum('bghqd,bgkd->bghqk', qc, kwc).astype(jnp.float32) * scale
        p, _, den = masked_exp(s, wmask, -1)
        o_win = jnp.einsum('bghqk,bgkd->bghqd', p, vwc) / den
        o = gc[..., 0:1] * o_cmp + gc[..., 1:2] * o_slc + gc[..., 2:3] * o_win
        return o.astype(q.dtype)

    outs = lax.map(chunk, jnp.arange(S // Q_CHUNK) * Q_CHUNK)
    return outs.transpose(1, 0, 4, 2, 3, 5).reshape(B, S, Hb * hd)


def causal_dwconv(a, w, b):
    F = a.shape[-1]
    y = lax.conv_general_dilated(a, w[:, None, :], window_strides=(1,), padding=[(CONV_W - 1, 0)],
                                 dimension_numbers=('NWC', 'WIO', 'NWC'), feature_group_count=F)
    return y + b


def setup_inputs(seed: int = 0) -> dict:
    key = jax.random.key(seed)
    ks = jax.random.split(key, 20)
    L, D, hd, F = DEPTH, D_MODEL, HEAD_DIM, D_FF

    def n(k, shape, s):
        return jax.random.normal(k, shape, jnp.float32) * s

    return {
        'x': n(ks[0], (BATCH, SEQ, D), 1.0),
        'c': n(ks[1], (BATCH, D), 1.0),
        'w_ada': n(ks[2], (L, D, 6 * D), 0.5 * D ** -0.5),
        'b_ada': n(ks[3], (L, 6 * D), 0.01),
        'w_in': n(ks[4], (L, D, IN_WIDTH), D ** -0.5),
        'pe_cmp': n(ks[5], (L, CMP_LEN, hd), 0.02),
        'w_ck1': n(ks[6], (L, CMP_LEN * hd, CMP_HIDDEN), (CMP_LEN * hd) ** -0.5),
        'w_ck2': n(ks[7], (L, CMP_HIDDEN, hd), CMP_HIDDEN ** -0.5),
        'w_cv1': n(ks[8], (L, CMP_LEN * hd, CMP_HIDDEN), (CMP_LEN * hd) ** -0.5),
        'w_cv2': n(ks[9], (L, CMP_HIDDEN, hd), CMP_HIDDEN ** -0.5),
        'w_o': n(ks[10], (L, MIX_WIDTH, D), BETA * MIX_WIDTH ** -0.5),
        'ln1_g': 1.0 + n(ks[11], (L, D), 0.01),
        'ln1_b': n(ks[12], (L, D), 0.01),
        'w_up': n(ks[13], (L, D, 2 * F), D ** -0.5),
        'conv_w': n(ks[14], (L, CONV_W, F), CONV_W ** -0.5),
        'conv_b': n(ks[15], (L, F), 0.01),
        'w_down': n(ks[16], (L, F, D), BETA * F ** -0.5),
        'ln2_g': 1.0 + n(ks[17], (L, D), 0.01),
        'ln2_b': n(ks[18], (L, D), 0.01),
    }


def reference(x, c, w_ada, b_ada, w_in, pe_cmp, w_ck1, w_ck2, w_cv1, w_cv2, w_o, ln1_g, ln1_b,
              w_up, conv_w, conv_b, w_down, ln2_g, ln2_b):
    B, S, D = x.shape
    hd = HEAD_DIM
    pos = jnp.arange(S)
    split_at = np.cumsum(IN_SPLITS)[:-1].tolist()

    def heads(t, nh):
        return t.reshape(B, S, nh, hd).transpose(0, 2, 1, 3)

    for l in range(DEPTH):
        mod = jax.nn.silu(c) @ w_ada[l] + b_ada[l]
        sh1, sc1, g1, sh2, sc2, g2 = [m[:, None, :] for m in jnp.split(mod, 6, axis=-1)]
        u = layer_norm(x) * (1 + sc1) + sh1
        qa, ka, va, qb, kc, vc, ksl, vsl, kw, vw, gl = jnp.split(u @ w_in[l], split_at, axis=-1)
        o_a = dilated_attention(partial_rope(heads(qa, N_HEADS_A), pos),
                                partial_rope(heads(ka, N_HEADS_A), pos),
                                heads(va, N_HEADS_A))
        o_a = o_a.transpose(0, 2, 1, 3).reshape(B, S, N_HEADS_A * hd)
        o_b = nsa_attention(partial_rope(heads(qb, N_HEADS_B), pos),
                            partial_rope(heads(kc, NSA_GROUPS), pos), heads(vc, NSA_GROUPS),
                            partial_rope(heads(ksl, NSA_GROUPS), pos), heads(vsl, NSA_GROUPS),
                            partial_rope(heads(kw, NSA_GROUPS), pos), heads(vw, NSA_GROUPS),
                            gl, pe_cmp[l], w_ck1[l], w_ck2[l], w_cv1[l], w_cv2[l])
        y = jnp.concatenate([o_a, o_b], axis=-1) @ w_o[l]
        x = layer_norm(ALPHA * x + g1 * y, ln1_g[l], ln1_b[l])
        u = layer_norm(x) * (1 + sc2) + sh2
        a_gate, a_val = jnp.split(u @ w_up[l], 2, axis=-1)
        h = jax.nn.gelu(causal_dwconv(a_gate, conv_w[l], conv_b[l])) * a_val
        x = layer_norm(ALPHA * x + g2 * (h @ w_down[l]), ln2_g[l], ln2_b[l])
    return x
```

```cpp
#include <hip/hip_runtime.h>
#include <hip/hip_cooperative_groups.h>
#include <cstdio>
#include <cstdint>
namespace cg = cooperative_groups;

#define LAS __attribute__((address_space(3)))
#define DI __device__ __forceinline__
typedef unsigned short bf16_t;
typedef short bf16x8 __attribute__((ext_vector_type(8)));
typedef float f32x4 __attribute__((ext_vector_type(4)));
typedef float f32x2 __attribute__((ext_vector_type(2)));
typedef float f32x16 __attribute__((ext_vector_type(16)));
typedef unsigned u32x4 __attribute__((ext_vector_type(4)));
typedef unsigned u32x2 __attribute__((ext_vector_type(2)));
typedef __bf16 bf16x2_t __attribute__((ext_vector_type(2)));

constexpr int BATCH = 4, SEQ = 8192, DM = 1024, MROWS = BATCH * SEQ, HD = 64;
constexpr int NIN = 2840, NINP = 3072, FF = 2816, NUP = 2 * FF;
constexpr int NHA = 8, NHB = 8, NG = 2;
constexpr int NCP = 512;
constexpr float ALPHA = 1.189207115002721f, LN_EPS = 1e-5f;
constexpr float C2 = 0.125f * 1.4426950408889634f;
constexpr float LN2F = 0.6931471805599453f;
constexpr float NEGBIG = -1e30f;

constexpr size_t MiB = 1u << 20;
constexpr size_t WS_MOD = 0;
constexpr size_t WS_CTR = 512 * 1024;
constexpr size_t WS_BAR = 512 * 1024 + 65536;
constexpr size_t WS_ROPE = 1 * MiB;
constexpr size_t WS_CB = 1 * MiB + 512 * 1024;
constexpr size_t WS_W2C = 1 * MiB + 768 * 1024;
constexpr size_t WS_WIN = 2 * MiB;
constexpr size_t WS_WO = 8 * MiB;
constexpr size_t WS_WUP = 10 * MiB;
constexpr size_t WS_WDN = 21 * MiB;
constexpr size_t WS_WC1 = 27 * MiB;
constexpr size_t WS_GATES = 29 * MiB;
constexpr size_t WS_U = 32 * MiB;
constexpr size_t WS_QA = 96 * MiB, WS_KA = 128 * MiB, WS_VAT = 160 * MiB;
constexpr size_t WS_QB = 256 * MiB, WS_KC = 288 * MiB, WS_VC = 296 * MiB, WS_KS = 304 * MiB, WS_VST = 312 * MiB, WS_KW = 320 * MiB, WS_VWT = 328 * MiB;
constexpr size_t WS_HID = 336 * MiB;
constexpr size_t WS_KCC = 340 * MiB;
constexpr size_t WS_VCCT = 340 * MiB + 512 * 1024;
constexpr size_t WS_LSE = 341 * MiB;
constexpr size_t WS_OP = 344 * MiB;
constexpr size_t WS_CAT = 440 * MiB;
constexpr size_t WS_H = 96 * MiB;
constexpr size_t WS_EDGE = 280 * MiB;
constexpr size_t WS_FIXG = 284 * MiB;
constexpr size_t WS_FIXV = 288 * MiB;
constexpr size_t WS_END = 504 * MiB;

DI unsigned f2bf(float f) { unsigned u = __builtin_bit_cast(unsigned, f); return (u + 0x7fffu + ((u >> 16) & 1u)) >> 16; }
DI unsigned pk2(float lo, float hi) { f32x2 v = {lo, hi}; bf16x2_t b = __builtin_convertvector(v, bf16x2_t); return __builtin_bit_cast(unsigned, b); }
DI float bf2f(unsigned short h) { return __builtin_bit_cast(float, (unsigned)h << 16); }
DI float gelu_tanh(float x) { const float u = 0.7978845608028654f * (x + 0.044715f * x * x * x); return x * __builtin_amdgcn_rcpf(1.0f + __builtin_amdgcn_exp2f(-2.0f * 1.4426950408889634f * u)); }
DI float sigmoidf_(float x) { return 1.0f / (1.0f + __expf(-x)); }
DI float wave_sum(float v) {
#pragma unroll
    for (int o = 1; o < 64; o <<= 1) v += __shfl_xor(v, o);
    return v;
}
template <int CTRL> DI float dppf(float x) { return __builtin_bit_cast(float, __builtin_amdgcn_update_dpp(0, __builtin_bit_cast(int, x), CTRL, 0xf, 0xf, true)); }

namespace pg8 {
constexpr int BM = 256, BK = 64, HALF = 128, HTB = HALF * BK * 2, STAGE_BYTES = 8 * HTB, NXCD = 8, WGM = 8;
DI int lds_byte(int r, int c) { const int st = (r >> 4) * 2 + (c >> 5), rr = r & 15, cc = c & 31, ob = rr * 64 + cc * 2; return st * 1024 + (ob ^ (((ob >> 9) & 1) << 5)); }
DI void stage_rc(int b, int& R, int& C) { const int st = b / 1024, sb = b % 1024, swz = sb ^ (((sb >> 9) & 1) << 5); R = (st >> 1) * 16 + swz / 64; C = (st & 1) * 32 + (swz % 64) / 2; }
DI int perm32(int rho) { const int n = rho >> 4, i = rho & 15; return 8 * (i >> 2) + 4 * n + (i & 3); }
struct Unit { int pm, pn; };
struct Gemm { const bf16_t* A; const bf16_t* Bt; int M, N, K, lda; };
struct StaticOrder {
    int nM, nN, nwg, G, c;
    DI void init(int M, int N, int G_, int c_) { nM = M / BM; nN = N / BM; nwg = nM * nN; G = G_; c = c_; }
    DI bool next(int i, Unit& u) const {
        const long L = (long)i * G + c; if (L >= nwg) return false;
        int wgid = (int)L; { const int q = nwg / NXCD, r = nwg % NXCD, xcd = wgid % NXCD, off = wgid / NXCD; wgid = (xcd < r ? xcd * (q + 1) : r * (q + 1) + (xcd - r) * q) + off; }
        const int nig = WGM * nN, gid = wgid / nig, fm = gid * WGM, gsz = (nM - fm) < WGM ? (nM - fm) : WGM;
        u.pm = fm + ((wgid % nig) % gsz); u.pn = (wgid % nig) / gsz; return true;
    }
};
struct OneUnit { int pm; DI bool next(int i, Unit& u) const { if (i > 0) return false; u.pm = pm; u.pn = 0; return true; } };

template <class Epi, class Sched>
DI void gemm_phase(LAS unsigned char* lds, const Gemm g, const Sched& S, const Epi& E) {
    int tid = threadIdx.x; asm volatile("" : "+v"(tid));
    const int wid = __builtin_amdgcn_readfirstlane(tid >> 6), lane = tid & 63, wr = wid >> 2, wc = wid & 3, fr = lane & 15, fq = lane >> 4;
    const int K = g.K, nt = K / BK, lda = g.lda;
    unsigned voffA[2], voffB[2];
#pragma unroll
    for (int i = 0; i < 2; ++i) { int R, C; stage_rc(tid * 16 + i * 8192, R, C); const int Rb = Epi::PERM ? ((R & ~31) + perm32(R & 31)) : R;
        voffA[i] = (unsigned)(R * lda + C) * 2u; voffB[i] = (unsigned)(Rb * K + C) * 2u; }
    const size_t kstep = (size_t)(BK * 2);
    const size_t hstepA = (size_t)HALF * lda * 2, hstepB = (size_t)HALF * K * 2;
    const size_t tstepA = 2 * hstepA, tstepB = 2 * hstepB;
    const unsigned ldsw = (unsigned)wid * 1024u;
    const int aoff = lds_byte(wr * 64 + fr, fq * 8), boff = lds_byte(wc * 32 + fr, fq * 8);
#define PG8_SA(b, h) (((b) * 2 + (h)) * HTB)
#define PG8_SB(b, h) ((4 + (b) * 2 + (h)) * HTB)
#define PG8_STAGE(bufoff, gbase, voff) do { _Pragma("unroll") for (int _i = 0; _i < 2; ++_i) \
        __builtin_amdgcn_global_load_lds((const unsigned*)((const char*)(gbase) + (voff)[_i]), (LAS unsigned*)(lds + (bufoff) + ldsw + _i * 8192), 16, 0, 0); } while (0)
#define PG8_LDA(dst, b, h) do { _Pragma("unroll") for (int m = 0; m < 4; ++m) _Pragma("unroll") for (int k = 0; k < 2; ++k) dst[m][k] = *(const LAS bf16x8*)(lds + PG8_SA(b, h) + aoff + m * 2048 + k * 1024); } while (0)
#define PG8_LDB(dst, b, h) do { _Pragma("unroll") for (int n = 0; n < 2; ++n) _Pragma("unroll") for (int k = 0; k < 2; ++k) dst[n][k] = *(const LAS bf16x8*)(lds + PG8_SB(b, h) + boff + n * 2048 + k * 1024); } while (0)
#define PG8_MMA(ai, bj, At, Bt) do { __builtin_amdgcn_s_setprio(1); _Pragma("unroll") for (int m = 0; m < 4; ++m) _Pragma("unroll") for (int n = 0; n < 2; ++n) _Pragma("unroll") for (int k = 0; k < 2; ++k) \
        acc[ai][bj][m][n] = __builtin_amdgcn_mfma_f32_16x16x32_bf16(Bt[n][k], At[m][k], acc[ai][bj][m][n], 0, 0, 0); __builtin_amdgcn_s_setprio(0); } while (0)
#define PG8_WAIT_V(n) asm volatile("s_waitcnt vmcnt(" #n ")" ::: "memory")
#define PG8_WAIT_L(n) asm volatile("s_waitcnt lgkmcnt(" #n ")" ::: "memory")
#define PG8_BAR __builtin_amdgcn_s_barrier()
#define PG8_SCHED __builtin_amdgcn_sched_barrier(0)
    Unit cur, nxt; int ui = 0;
    if (!S.next(0, cur)) return;
    f32x4 acc[2][2][4][2];
#pragma unroll
    for (int a = 0; a < 2; ++a)
#pragma unroll
        for (int b = 0; b < 2; ++b)
#pragma unroll
            for (int m = 0; m < 4; ++m)
#pragma unroll
                for (int n = 0; n < 2; ++n) acc[a][b][m][n] = (f32x4){0.f, 0.f, 0.f, 0.f};
    bf16x8 At[4][2], B0[2][2], B1[2][2];
    const char* cA = (const char*)g.A + (size_t)cur.pm * tstepA; const char* cB = (const char*)g.Bt + (size_t)cur.pn * tstepB;
    PG8_STAGE(PG8_SB(0, 0), cB, voffB); PG8_STAGE(PG8_SB(0, 1), cB + hstepB, voffB); PG8_STAGE(PG8_SA(0, 0), cA, voffA); PG8_STAGE(PG8_SA(0, 1), cA + hstepA, voffA);
    if (wr == 1) PG8_BAR;
    PG8_WAIT_V(2); PG8_BAR;
    PG8_STAGE(PG8_SB(1, 0), cB + kstep, voffB); PG8_STAGE(PG8_SA(1, 0), cA + kstep, voffA); PG8_STAGE(PG8_SB(1, 1), cB + hstepB + kstep, voffB);
    PG8_WAIT_V(6); PG8_BAR;
    for (;;) {
        const bool has_next = S.next(ui + 1, nxt);
        const char* nA = has_next ? (const char*)g.A + (size_t)nxt.pm * tstepA : cA; const char* nB = has_next ? (const char*)g.Bt + (size_t)nxt.pn * tstepB : cB;
        for (int t = 0; t < nt; t += 2) {
            const bool last = (t == nt - 2);
            const char* a1 = cA + (size_t)(t + 1) * kstep;
            const char* a2 = last ? nA : cA + (size_t)(t + 2) * kstep; const char* b2 = last ? nB : cB + (size_t)(t + 2) * kstep;
            const char* a3 = a2 + kstep; const char* b3 = b2 + kstep;
            PG8_LDB(B0, 0, 0); PG8_LDB(B1, 0, 1); PG8_SCHED; PG8_LDA(At, 0, 0); PG8_STAGE(PG8_SA(1, 1), a1 + hstepA, voffA);
            PG8_WAIT_V(8); PG8_WAIT_L(0); PG8_BAR; PG8_MMA(0, 0, At, B0); PG8_MMA(0, 1, At, B1); PG8_BAR; PG8_SCHED;
            PG8_LDA(At, 0, 1); PG8_STAGE(PG8_SB(0, 0), b2, voffB); PG8_STAGE(PG8_SB(0, 1), b2 + hstepB, voffB); PG8_STAGE(PG8_SA(0, 0), a2, voffA);
            PG8_WAIT_V(8); PG8_WAIT_L(0); PG8_BAR; PG8_MMA(1, 0, At, B0); PG8_MMA(1, 1, At, B1); PG8_BAR; PG8_SCHED;
            PG8_LDB(B0, 1, 0); PG8_LDB(B1, 1, 1); PG8_SCHED; PG8_LDA(At, 1, 0); PG8_STAGE(PG8_SA(0, 1), a2 + hstepA, voffA);
            PG8_WAIT_V(8); PG8_WAIT_L(0); PG8_BAR; PG8_MMA(0, 0, At, B0); PG8_MMA(0, 1, At, B1); PG8_BAR; PG8_SCHED;
            PG8_LDA(At, 1, 1); PG8_STAGE(PG8_SB(1, 0), b3, voffB); PG8_STAGE(PG8_SB(1, 1), b3 + hstepB, voffB); PG8_STAGE(PG8_SA(1, 0), a3, voffA);
            PG8_WAIT_V(8); PG8_WAIT_L(0); PG8_BAR; PG8_MMA(1, 0, At, B0); PG8_MMA(1, 1, At, B1); PG8_BAR; PG8_SCHED;
        }
        if (wr == 0) PG8_BAR;
        E(acc, cur, wr, wc, fr, fq);
        if (!has_next) break;
#pragma unroll
        for (int a = 0; a < 2; ++a)
#pragma unroll
            for (int b = 0; b < 2; ++b)
#pragma unroll
                for (int m = 0; m < 4; ++m)
#pragma unroll
                    for (int n = 0; n < 2; ++n) acc[a][b][m][n] = (f32x4){0.f, 0.f, 0.f, 0.f};
        cur = nxt; cA = nA; cB = nB; ++ui;
        if (wr == 1) PG8_BAR;
    }
    PG8_WAIT_V(0);
    PG8_BAR;
#undef PG8_SA
#undef PG8_SB
#undef PG8_STAGE
#undef PG8_LDA
#undef PG8_LDB
#undef PG8_MMA
#undef PG8_WAIT_V
#undef PG8_WAIT_L
#undef PG8_BAR
#undef PG8_SCHED
}
}
using pg8::Unit;
typedef f32x4 AccT[2][2][4][2];

struct EpiIn {
    static constexpr bool PERM = true;
    unsigned char* ws; const float* rope;
    DI void operator()(const AccT& acc, const Unit& u, int wr, int wc, int fr, int fq) const {
        const int lane = threadIdx.x & 63;
#pragma unroll
        for (int bj = 0; bj < 2; ++bj) {
            const int seg = u.pn * 2 + bj;
            if (seg >= 23) continue;
            const int hs = wc >> 1;
            const int d0 = 32 * (wc & 1) + 8 * fq;
            int kind;
            bf16_t* base = nullptr; int nh = 8, head = 0; float sc = 1.f;
            if (seg < 4)       { kind = 0; base = (bf16_t*)(ws + WS_QA); head = seg * 2 + hs; sc = C2; }
            else if (seg < 8)  { kind = 0; base = (bf16_t*)(ws + WS_KA); head = (seg - 4) * 2 + hs; }
            else if (seg < 12) { kind = 3; base = (bf16_t*)(ws + WS_VAT); head = (seg - 8) * 2 + hs; }
            else if (seg < 16) { kind = 0; base = (bf16_t*)(ws + WS_QB); head = (seg - 12) * 2 + hs; sc = C2; }
            else if (seg == 16) { kind = 0; base = (bf16_t*)(ws + WS_KC); nh = 2; head = hs; }
            else if (seg == 17) { kind = 3; base = (bf16_t*)(ws + WS_VC); nh = 2; head = hs; }
            else if (seg == 18) { kind = 0; base = (bf16_t*)(ws + WS_KS); nh = 2; head = hs; }
            else if (seg == 19) { kind = 3; base = (bf16_t*)(ws + WS_VST); nh = 2; head = hs; }
            else if (seg == 20) { kind = 0; base = (bf16_t*)(ws + WS_KW); nh = 2; head = hs; }
            else if (seg == 21) { kind = 3; base = (bf16_t*)(ws + WS_VWT); nh = 2; head = hs; }
            else { kind = 4; }
            const bool do_rope = (kind == 0) && ((wc & 1) == 0);
#pragma unroll
            for (int ai = 0; ai < 2; ++ai)
#pragma unroll
                for (int m = 0; m < 4; ++m) {
                    const int row = u.pm * 256 + ai * 128 + wr * 64 + m * 16 + fr;
                    const int b = row >> 13, s = row & (SEQ - 1);
                    float v[8];
#pragma unroll
                    for (int n = 0; n < 2; ++n)
#pragma unroll
                        for (int j = 0; j < 4; ++j) v[n * 4 + j] = acc[ai][bj][m][n][j];
                    if (do_rope) {
                        const f32x4* rp = (const f32x4*)(rope + (size_t)s * 16);
#pragma unroll
                        for (int e2 = 0; e2 < 4; ++e2) {
                            f32x4 cs = (fq < 2) ? rp[e2] : (f32x4){1.f, 0.f, 1.f, 0.f};
#pragma unroll
                            for (int q = 0; q < 2; ++q) {
                                const int e = e2 * 2 + q; const float c = cs[2 * q], sn = cs[2 * q + 1];
                                const float other = __shfl_xor(v[e], 16);
                                const float r0 = v[e] * c - other * sn;
                                const float r1 = other * sn + v[e] * c;
                                v[e] = (fq == 0) ? r0 : ((fq == 1) ? r1 : v[e]);
                            }
                        }
                    }
                    if (kind == 0 || kind == 3) {
                        u32x4 w; w.x = pk2(v[0] * sc, v[1] * sc); w.y = pk2(v[2] * sc, v[3] * sc); w.z = pk2(v[4] * sc, v[5] * sc); w.w = pk2(v[6] * sc, v[7] * sc);
                        *(u32x4*)(base + ((size_t)(b * nh + head) * SEQ + s) * HD + d0) = w;
                    } else if (kind == 2 || kind == 1) {
                        const size_t hb = (size_t)(b * nh + head) * HD * SEQ + d0 * 32;
                        bf16_t* p1 = base + hb + (size_t)(s >> 5) * 2048 + (s & 31);
                        const int g4 = (s & 3) * (SEQ / 4) + (s >> 2);
                        bf16_t* p4 = base + (size_t)MROWS * 512 + hb + (size_t)(g4 >> 5) * 2048 + (g4 & 31);
#pragma unroll
                        for (int e = 0; e < 8; ++e) {
                            const float a1 = dppf<0x101>(v[e]), a2 = dppf<0x102>(v[e]), a3 = dppf<0x103>(v[e]);
                            if ((fr & 3) == 0) { u32x2 w; w.x = pk2(v[e], a1); w.y = pk2(a2, a3); *(u32x2*)(p1 + e * 32) = w; }
                            if (kind == 1) {
                                const float c1 = dppf<0x104>(v[e]), c2 = dppf<0x108>(v[e]), c3 = dppf<0x10C>(v[e]);
                                if (fr < 4) { u32x2 w; w.x = pk2(v[e], c1); w.y = pk2(c2, c3); *(u32x2*)(p4 + e * 32) = w; }
                            }
                        }
                    } else {
                        const int c0 = 32 * wc + 8 * fq;
                        if (c0 < 24) { float* gp = (float*)(ws + WS_GATES) + (size_t)row * 24 + c0;
#pragma unroll
                            for (int e = 0; e < 8; ++e) gp[e] = sigmoidf_(v[e]); }
                    }
                }
            if (kind == 1) {
#pragma unroll
                for (int ai = 0; ai < 2; ++ai) {
                    const int row0 = u.pm * 256 + ai * 128 + wr * 64 + fr;
                    const int b = row0 >> 13, s0 = row0 & (SEQ - 1);
                    const int g16 = (s0 & 15) * (SEQ / 16) + (s0 >> 4);
                    bf16_t* p16 = base + (size_t)2 * MROWS * 512 + (size_t)(b * nh + head) * HD * SEQ + d0 * 32 + (size_t)(g16 >> 5) * 2048 + (g16 & 31);
#pragma unroll
                    for (int n = 0; n < 2; ++n)
#pragma unroll
                        for (int j = 0; j < 4; ++j) { u32x2 w; w.x = pk2(acc[ai][bj][0][n][j], acc[ai][bj][1][n][j]); w.y = pk2(acc[ai][bj][2][n][j], acc[ai][bj][3][n][j]); *(u32x2*)(p16 + (n * 4 + j) * 32) = w; }
                }
            }
        }
        (void)lane;
    }
};
struct EpiHid {
    static constexpr bool PERM = true;
    bf16_t* O; const float* bias;
    DI void operator()(const AccT& acc, const Unit& u, int wr, int wc, int fr, int fq) const {
#pragma unroll
        for (int bj = 0; bj < 2; ++bj) {
            const int col0 = bj * 128 + wc * 32 + 8 * fq;
            float bv[8];
#pragma unroll
            for (int e = 0; e < 8; ++e) bv[e] = bias[col0 + e];
#pragma unroll
            for (int ai = 0; ai < 2; ++ai)
#pragma unroll
                for (int m = 0; m < 4; ++m) {
                    const int row = u.pm * 256 + ai * 128 + wr * 64 + m * 16 + fr;
                    float v[8];
#pragma unroll
                    for (int n = 0; n < 2; ++n)
#pragma unroll
                        for (int j = 0; j < 4; ++j) v[n * 4 + j] = gelu_tanh(acc[ai][bj][m][n][j] + bv[n * 4 + j]);
                    u32x4 w; w.x = pk2(v[0], v[1]); w.y = pk2(v[2], v[3]); w.z = pk2(v[4], v[5]); w.w = pk2(v[6], v[7]);
                    *(u32x4*)(O + (size_t)row * 256 + col0) = w;
                }
        }
    }
};
struct EpiPlain {
    static constexpr bool PERM = true;
    bf16_t* O; int ldc;
    DI void operator()(const AccT& acc, const Unit& u, int wr, int wc, int fr, int fq) const {
#pragma unroll
        for (int bj = 0; bj < 2; ++bj) {
            const int col0 = u.pn * 256 + bj * 128 + wc * 32 + 8 * fq;
#pragma unroll
            for (int ai = 0; ai < 2; ++ai)
#pragma unroll
                for (int m = 0; m < 4; ++m) {
                    const int row = u.pm * 256 + ai * 128 + wr * 64 + m * 16 + fr;
                    u32x4 w; w.x = pk2(acc[ai][bj][m][0][0], acc[ai][bj][m][0][1]); w.y = pk2(acc[ai][bj][m][0][2], acc[ai][bj][m][0][3]);
                    w.z = pk2(acc[ai][bj][m][1][0], acc[ai][bj][m][1][1]); w.w = pk2(acc[ai][bj][m][1][2], acc[ai][bj][m][1][3]);
                    *(u32x4*)(O + (size_t)row * ldc + col0) = w;
                }
        }
    }
};
struct EpiRes {
    static constexpr bool PERM = false;
    const float* base; float* out; const float* gate;
    DI void operator()(const AccT& acc, const Unit& u, int wr, int wc, int fr, int fq) const {
#pragma unroll
        for (int bj = 0; bj < 2; ++bj)
#pragma unroll
            for (int n = 0; n < 2; ++n) {
                const int col = u.pn * 256 + bj * 128 + wc * 32 + n * 16 + 4 * fq;
                const int b = (u.pm * 256) >> 13;
                const f32x4 gv = *(const f32x4*)(gate + (size_t)b * 6144 + col);
#pragma unroll
                for (int ai = 0; ai < 2; ++ai)
#pragma unroll
                    for (int m = 0; m < 4; ++m) {
                        const size_t off = (size_t)(u.pm * 256 + ai * 128 + wr * 64 + m * 16 + fr) * DM + col;
                        const f32x4 bs = *(const f32x4*)(base + off);
                        *(f32x4*)(out + off) = bs * ALPHA + gv * acc[ai][bj][m][n];
                    }
            }
    }
};
struct EpiUp {
    static constexpr bool PERM = true;
    bf16_t* H; const float* cw; const float* cb; float* edge; float* fixg; float* fixv; LAS float* xch;
    DI void operator()(const AccT& acc, const Unit& u, int wr, int wc, int fr, int fq) const {
        const int fcol = 32 * wc + 8 * fq;
        const int f0 = u.pn * 128 + fcol;
        if (fr >= 14) {
#pragma unroll
            for (int ai = 0; ai < 2; ++ai) {
                LAS float* xp = xch + ((ai * 2 + wr) * 2 + (fr - 14)) * 128 + fcol;
                *(LAS f32x4*)(xp) = acc[ai][0][3][0]; *(LAS f32x4*)(xp + 4) = acc[ai][0][3][1];
                if (ai == 1 && wr == 1) { float* ep = edge + ((size_t)u.pm * 2 + (fr - 14)) * FF + f0; *(f32x4*)ep = acc[1][0][3][0]; *(f32x4*)(ep + 4) = acc[1][0][3][1]; }
            }
        }
        asm volatile("s_waitcnt lgkmcnt(0)" ::: "memory"); __builtin_amdgcn_s_barrier(); asm volatile("" ::: "memory");
        float w0[8], w1[8], w2[8], bb[8];
#pragma unroll
        for (int e = 0; e < 8; ++e) { w0[e] = cw[f0 + e]; w1[e] = cw[FF + f0 + e]; w2[e] = cw[2 * FF + f0 + e]; bb[e] = cb[f0 + e]; }
#pragma unroll
        for (int ai = 0; ai < 2; ++ai) {
            float x62[8], x63[8];
            const bool has_src = !(ai == 0 && wr == 0);
            const int src = (wr == 1) ? (ai * 2) : 1;
#pragma unroll
            for (int e = 0; e < 8; ++e) { x62[e] = 0.f; x63[e] = 0.f; }
            if (has_src && fr < 2) {
                const LAS float* xp = xch + (src * 2) * 128 + fcol;
#pragma unroll
                for (int e = 0; e < 8; ++e) { x62[e] = xp[e]; x63[e] = xp[128 + e]; }
            }
#pragma unroll
            for (int m = 0; m < 4; ++m) {
                const int rt = ai * 128 + wr * 64 + m * 16 + fr;
                const int row = u.pm * 256 + rt;
                float hv[8];
#pragma unroll
                for (int n = 0; n < 2; ++n)
#pragma unroll
                    for (int j = 0; j < 4; ++j) {
                        const int e = n * 4 + j;
                        const float a = acc[ai][0][m][n][j];
                        float p1 = dppf<0x111>(a), p2 = dppf<0x112>(a);
                        float q1, q2;
                        if (m > 0) { const float am = acc[ai][0][m > 0 ? m - 1 : 0][n][j]; q1 = dppf<0x10F>(am); q2 = dppf<0x10E>(am); }
                        else { q1 = x63[e]; q2 = (fr == 0) ? x62[e] : x63[e]; }
                        if (fr < 1) p1 = q1;
                        if (fr < 2) p2 = q2;
                        const float gpre = w0[e] * p2 + w1[e] * p1 + w2[e] * a + bb[e];
                        hv[e] = gelu_tanh(gpre) * acc[ai][1][m][n][j];
                        if (ai == 0 && wr == 0 && m == 0 && fr < 2) {
                            fixg[((size_t)u.pm * 2 + fr) * FF + f0 + e] = gpre; fixv[((size_t)u.pm * 2 + fr) * FF + f0 + e] = acc[0][1][0][n][j];
                        }
                    }
                u32x4 w; w.x = pk2(hv[0], hv[1]); w.y = pk2(hv[2], hv[3]); w.z = pk2(hv[4], hv[5]); w.w = pk2(hv[6], hv[7]);
                *(u32x4*)(H + (size_t)row * FF + f0) = w;
            }
        }
    }
};

#define MFMA32(a, b, c) __builtin_amdgcn_mfma_f32_32x32x16_bf16((a), (b), (c), 0, 0, 0)
DI int kvmap(int i) { return (i & 0x13) | ((i & 4) << 1) | ((i & 8) >> 1); }
DI int kvl_of(int r, int hi) { return 16 * (r >> 3) + 8 * hi + (r & 7); }
DI bf16x8 pack8(const f32x16& s, int b) { u32x4 w; w.x = pk2(s[b], s[b + 1]); w.y = pk2(s[b + 2], s[b + 3]); w.z = pk2(s[b + 4], s[b + 5]); w.w = pk2(s[b + 6], s[b + 7]); return __builtin_bit_cast(bf16x8, w); }
DI f32x16 splat16(float v) { f32x16 r;
#pragma unroll
    for (int i = 0; i < 16; ++i) r[i] = v;
    return r; }
template <int CTRL> DI int dppi(int x) { return __builtin_amdgcn_update_dpp(0, x, CTRL, 0xf, 0xf, true); }
DI int sum8(int c) { c += dppi<0xB1>(c); c += dppi<0x4E>(c); c += dppi<0x141>(c); return c; }
struct FA2 { float mref, l; bool inited; f32x16 o0, o1; };
DI void fa2_init(FA2& st) { st.mref = 0.f; st.l = 0.f; st.inited = false;
#pragma unroll
    for (int r = 0; r < 16; ++r) { st.o0[r] = 0.f; st.o1[r] = 0.f; } }
DI void fa2_step(FA2& st, const bf16x8 (&kf)[4], const bf16x8 (&vf)[2][2], const bf16x8 (&qf)[4], bool sel, bool needmask, unsigned vm) {
    f32x16 s = MFMA32(kf[0], qf[0], splat16(0.f));
    s = MFMA32(kf[1], qf[1], s); s = MFMA32(kf[2], qf[2], s); s = MFMA32(kf[3], qf[3], s);
    if (needmask) {
#pragma unroll
        for (int r = 0; r < 16; ++r) s[r] = ((vm >> r) & 1u) ? s[r] : NEGBIG;
    }
    float r0 = fmaxf(fmaxf(s[0], s[1]), s[2]), r1 = fmaxf(fmaxf(s[3], s[4]), s[5]);
    r0 = fmaxf(fmaxf(r0, s[6]), s[7]); r1 = fmaxf(fmaxf(r1, s[8]), s[9]);
    r0 = fmaxf(fmaxf(r0, s[10]), s[11]); r1 = fmaxf(fmaxf(r1, s[12]), s[13]);
    float rm = fmaxf(fmaxf(r0, r1), fmaxf(s[14], s[15]));
    rm = fmaxf(rm, __shfl_xor(rm, 32));
    const bool valid = sel && (rm > -1e29f);
    const float rel = rm - st.mref;
    const bool need = valid && (rel > 8.0f || !st.inited);
    const float delta = need ? rel : 0.f;
    st.mref += delta;
    if (__builtin_expect(__any(need) != 0, 0)) {
        const float f = __builtin_amdgcn_exp2f(st.inited ? -delta : 0.f);
        asm volatile("s_nop 4\n\tv_mul_f32 %0, %0, %1" : "+v"(st.l) : "v"(f));
#pragma unroll
        for (int r = 0; r < 16; ++r) { asm volatile("v_mul_f32 %0, %0, %1" : "+v"(st.o0[r]) : "v"(f)); asm volatile("v_mul_f32 %0, %0, %1" : "+v"(st.o1[r]) : "v"(f)); }
    }
    st.inited = st.inited || valid;
    const float msub = sel ? st.mref : 1e30f;
    float ls0 = 0.f, ls1 = 0.f;
#pragma unroll
    for (int r = 0; r < 16; r += 2) { s[r] = __builtin_amdgcn_exp2f(s[r] - msub); s[r + 1] = __builtin_amdgcn_exp2f(s[r + 1] - msub); ls0 += s[r]; ls1 += s[r + 1]; }
    st.l += ls0 + ls1;
    const bf16x8 p0 = pack8(s, 0), p1 = pack8(s, 8);
    st.o0 = MFMA32(vf[0][0], p0, st.o0); st.o0 = MFMA32(vf[0][1], p1, st.o0);
    st.o1 = MFMA32(vf[1][0], p0, st.o1); st.o1 = MFMA32(vf[1][1], p1, st.o1);
}
typedef short v4i16_t __attribute__((ext_vector_type(4)));
DI void tr_offsets(int lane, int (&toff)[2][2][2]) {
    const int li = lane & 15, q = li >> 2, pp = li & 3, g = lane >> 4, hi = g >> 1;
#pragma unroll
    for (int db = 0; db < 2; ++db)
#pragma unroll
        for (int ks = 0; ks < 2; ++ks)
#pragma unroll
            for (int h4 = 0; h4 < 2; ++h4) {
                const int row = 16 * ks + 8 * hi + 4 * h4 + q, col = 32 * db + 16 * (g & 1) + 4 * pp;
                toff[db][ks][h4] = row * 128 + ((((col >> 3)) ^ ((row >> 1) & 7)) << 4) + (col & 4) * 2;
            }
}
DI void read_v_tr(const LAS unsigned char* tile, const int (&toff)[2][2][2], bf16x8 (&vf)[2][2]) {
#pragma unroll
    for (int db = 0; db < 2; ++db)
#pragma unroll
        for (int ks = 0; ks < 2; ++ks) {
            const v4i16_t lo = __builtin_amdgcn_ds_read_tr16_b64_v4i16((LAS v4i16_t*)(tile + toff[db][ks][0]));
            const v4i16_t hh = __builtin_amdgcn_ds_read_tr16_b64_v4i16((LAS v4i16_t*)(tile + toff[db][ks][1]));
            vf[db][ks] = (bf16x8){lo[0], lo[1], lo[2], lo[3], hh[0], hh[1], hh[2], hh[3]};
        }
}
DI void fa2_pair(FA2& st, const bf16x8 (&kA)[4], const bf16x8 (&vA)[2][2], const bf16x8 (&kB)[4], const bf16x8 (&vB)[2][2], const bf16x8 (&qf)[4],
                 bool sel, bool nmA, unsigned vmA, bool nmB, unsigned vmB) {
    f32x16 sa = MFMA32(kA[0], qf[0], splat16(0.f)), sb = MFMA32(kB[0], qf[0], splat16(0.f));
    sa = MFMA32(kA[1], qf[1], sa); sb = MFMA32(kB[1], qf[1], sb);
    sa = MFMA32(kA[2], qf[2], sa); sb = MFMA32(kB[2], qf[2], sb);
    sa = MFMA32(kA[3], qf[3], sa); sb = MFMA32(kB[3], qf[3], sb);
    if (nmA) {
#pragma unroll
        for (int r = 0; r < 16; ++r) sa[r] = ((vmA >> r) & 1u) ? sa[r] : NEGBIG;
    }
    if (nmB) {
#pragma unroll
        for (int r = 0; r < 16; ++r) sb[r] = ((vmB >> r) & 1u) ? sb[r] : NEGBIG;
    }
    float r0 = fmaxf(fmaxf(sa[0], sa[1]), sa[2]), r1 = fmaxf(fmaxf(sb[0], sb[1]), sb[2]);
#pragma unroll
    for (int r = 3; r < 15; r += 2) { r0 = fmaxf(fmaxf(r0, sa[r]), sa[r + 1]); r1 = fmaxf(fmaxf(r1, sb[r]), sb[r + 1]); }
    float rm = fmaxf(fmaxf(r0, r1), fmaxf(sa[15], sb[15]));
    rm = fmaxf(rm, __shfl_xor(rm, 32));
    const bool valid = sel && (rm > -1e29f);
    const float rel = rm - st.mref;
    const bool need = valid && (rel > 8.0f || !st.inited);
    const float delta = need ? rel : 0.f;
    st.mref += delta;
    if (__builtin_expect(__any(need) != 0, 0)) {
        const float f = __builtin_amdgcn_exp2f(st.inited ? -delta : 0.f);
        asm volatile("s_nop 4\n\tv_mul_f32 %0, %0, %1" : "+v"(st.l) : "v"(f));
#pragma unroll
        for (int r = 0; r < 16; ++r) { asm volatile("v_mul_f32 %0, %0, %1" : "+v"(st.o0[r]) : "v"(f)); asm volatile("v_mul_f32 %0, %0, %1" : "+v"(st.o1[r]) : "v"(f)); }
    }
    st.inited = st.inited || valid;
    const float msub = sel ? st.mref : 1e30f;
    float ls0 = 0.f, ls1 = 0.f;
#pragma unroll
    for (int r = 0; r < 16; ++r) { sa[r] = __builtin_amdgcn_exp2f(sa[r] - msub); sb[r] = __builtin_amdgcn_exp2f(sb[r] - msub); ls0 += sa[r]; ls1 += sb[r]; }
    st.l += ls0 + ls1;
    const bf16x8 pa0 = pack8(sa, 0), pa1 = pack8(sa, 8), pb0 = pack8(sb, 0), pb1 = pack8(sb, 8);
    st.o0 = MFMA32(vA[0][0], pa0, st.o0); st.o1 = MFMA32(vA[1][0], pa0, st.o1);
    st.o0 = MFMA32(vA[0][1], pa1, st.o0); st.o1 = MFMA32(vA[1][1], pa1, st.o1);
    st.o0 = MFMA32(vB[0][0], pb0, st.o0); st.o1 = MFMA32(vB[1][0], pb0, st.o1);
    st.o0 = MFMA32(vB[0][1], pb1, st.o0); st.o1 = MFMA32(vB[1][1], pb1, st.o1);
}
DI void fa2_pair_latev(FA2& st, const bf16x8 (&kA)[4], const LAS unsigned char* vtA, const bf16x8 (&kB)[4], const LAS unsigned char* vtB, const int (&toff)[2][2][2], const bf16x8 (&qf)[4],
                 bool sel, bool nmA, unsigned vmA, bool nmB, unsigned vmB) {
    f32x16 sa = MFMA32(kA[0], qf[0], splat16(0.f)), sb = MFMA32(kB[0], qf[0], splat16(0.f));
    sa = MFMA32(kA[1], qf[1], sa); sb = MFMA32(kB[1], qf[1], sb);
    sa = MFMA32(kA[2], qf[2], sa); sb = MFMA32(kB[2], qf[2], sb);
    sa = MFMA32(kA[3], qf[3], sa); sb = MFMA32(kB[3], qf[3], sb);
    if (nmA) {
#pragma unroll
        for (int r = 0; r < 16; ++r) sa[r] = ((vmA >> r) & 1u) ? sa[r] : NEGBIG;
    }
    if (nmB) {
#pragma unroll
        for (int r = 0; r < 16; ++r) sb[r] = ((vmB >> r) & 1u) ? sb[r] : NEGBIG;
    }
    float r0 = fmaxf(fmaxf(sa[0], sa[1]), sa[2]), r1 = fmaxf(fmaxf(sb[0], sb[1]), sb[2]);
#pragma unroll
    for (int r = 3; r < 15; r += 2) { r0 = fmaxf(fmaxf(r0, sa[r]), sa[r + 1]); r1 = fmaxf(fmaxf(r1, sb[r]), sb[r + 1]); }
    float rm = fmaxf(fmaxf(r0, r1), fmaxf(sa[15], sb[15]));
    rm = fmaxf(rm, __shfl_xor(rm, 32));
    const bool valid = sel && (rm > -1e29f);
    const float rel = rm - st.mref;
    const bool need = valid && (rel > 8.0f || !st.inited);
    const float delta = need ? rel : 0.f;
    st.mref += delta;
    if (__builtin_expect(__any(need) != 0, 0)) {
        const float f = __builtin_amdgcn_exp2f(st.inited ? -delta : 0.f);
        asm volatile("s_nop 4\n\tv_mul_f32 %0, %0, %1" : "+v"(st.l) : "v"(f));
#pragma unroll
        for (int r = 0; r < 16; ++r) { asm volatile("v_mul_f32 %0, %0, %1" : "+v"(st.o0[r]) : "v"(f)); asm volatile("v_mul_f32 %0, %0, %1" : "+v"(st.o1[r]) : "v"(f)); }
    }
    st.inited = st.inited || valid;
    const float msub = sel ? st.mref : 1e30f;
    float ls0 = 0.f, ls1 = 0.f;
#pragma unroll
    for (int r = 0; r < 16; ++r) { sa[r] = __builtin_amdgcn_exp2f(sa[r] - msub); sb[r] = __builtin_amdgcn_exp2f(sb[r] - msub); ls0 += sa[r]; ls1 += sb[r]; }
    st.l += ls0 + ls1;
    const bf16x8 pa0 = pack8(sa, 0), pa1 = pack8(sa, 8), pb0 = pack8(sb, 0), pb1 = pack8(sb, 8);
    asm volatile("" ::: "memory");
    bf16x8 vA[2][2], vB[2][2];
    read_v_tr(vtA, toff, vA); read_v_tr(vtB, toff, vB);
    st.o0 = MFMA32(vA[0][0], pa0, st.o0); st.o1 = MFMA32(vA[1][0], pa0, st.o1);
    st.o0 = MFMA32(vA[0][1], pa1, st.o0); st.o1 = MFMA32(vA[1][1], pa1, st.o1);
    st.o0 = MFMA32(vB[0][0], pb0, st.o0); st.o1 = MFMA32(vB[1][0], pb0, st.o1);
    st.o0 = MFMA32(vB[0][1], pb1, st.o0); st.o1 = MFMA32(vB[1][1], pb1, st.o1);
}
DI void load_k(bf16x8 (&kf)[4], const bf16_t* krow, int hi) {
#pragma unroll
    for (int kk = 0; kk < 4; ++kk) kf[kk] = *(const bf16x8*)(krow + 16 * kk + 8 * hi);
}
DI void load_vt(bf16x8 (&vf)[2][2], const bf16_t* vt, int i32, int hi) {
#pragma unroll
    for (int db = 0; db < 2; ++db)
#pragma unroll
        for (int ks = 0; ks < 2; ++ks) vf[db][ks] = *(const bf16x8*)(vt + (32 * db + i32) * 32 + 16 * ks + 8 * hi);
}
DI void store_o(bf16_t* dst, const f32x16& o0, const f32x16& o1, float scale, int hi) {
#pragma unroll
    for (int g4 = 0; g4 < 4; ++g4) {
        u32x2 a; a.x = pk2(o0[4 * g4] * scale, o0[4 * g4 + 1] * scale); a.y = pk2(o0[4 * g4 + 2] * scale, o0[4 * g4 + 3] * scale);
        u32x2 b; b.x = pk2(o1[4 * g4] * scale, o1[4 * g4 + 1] * scale); b.y = pk2(o1[4 * g4 + 2] * scale, o1[4 * g4 + 3] * scale);
        *(u32x2*)(dst + 8 * g4 + 4 * hi) = a; *(u32x2*)(dst + 32 + 8 * g4 + 4 * hi) = b;
    }
}
template <class KAddr, class VAddr, class NeedF, class MaskF>
DI void fa2_loop(FA2& st, const bf16x8 (&qf)[4], int t_first, int t_last, KAddr kaddr, VAddr vaddr, NeedF needmask, MaskF maskf, int i32, int hi) {
    if (t_first > t_last) return;
    bf16x8 kA[4], vA[2][2], kB[4], vB[2][2], kC[4], vC[2][2];
    load_k(kA, kaddr(t_first), hi); load_vt(vA, vaddr(t_first), i32, hi);
    if (t_first + 1 <= t_last) { load_k(kB, kaddr(t_first + 1), hi); load_vt(vB, vaddr(t_first + 1), i32, hi); }
#define FA2_STAGE(KC_, VC_, KN_, VN_, tt) do { const int t__ = (tt); if (t__ <= t_last) { \
        if (t__ + 2 <= t_last) { load_k(KN_, kaddr(t__ + 2), hi); load_vt(VN_, vaddr(t__ + 2), i32, hi); } \
        const bool nm__ = needmask(t__); unsigned vm__ = 0xffffu; if (nm__) vm__ = maskf(t__); \
        fa2_step(st, KC_, VC_, qf, true, nm__, vm__); } } while (0)
#pragma unroll 1
    for (int t = t_first; t <= t_last; t += 3) {
        FA2_STAGE(kA, vA, kC, vC, t);
        FA2_STAGE(kB, vB, kA, vA, t + 1);
        FA2_STAGE(kC, vC, kB, vB, t + 2);
    }
#undef FA2_STAGE
}

DI void dilated_block_unit(unsigned char* ws, LAS unsigned char* lds, int unit) {
    int tid = threadIdx.x; asm volatile("" : "+v"(tid));
    const int lane = tid & 63, wid = __builtin_amdgcn_readfirstlane(tid >> 6), i32 = lane & 31, hi = lane >> 5;
    const int p = unit >> 10; int rem = unit & 1023; const int bh = rem >> 5; rem &= 31;
    const int d = (p == 0) ? 1 : (p == 1 ? 4 : 16); const int L = SEQ / d, ng8 = L / 256;
    const int r = rem / ng8, ib0 = 8 * (rem % ng8), ib = ib0 + wid;
    const bf16_t* Q = (const bf16_t*)(ws + WS_QA) + (size_t)bh * SEQ * HD;
    const bf16_t* K = (const bf16_t*)(ws + WS_KA) + (size_t)bh * SEQ * HD;
    const bf16_t* V = (const bf16_t*)(ws + WS_VAT) + (size_t)bh * SEQ * HD;
    {
        const bf16_t* src; size_t tstride; unsigned dstoff;
        { const int w4 = wid & 3, row = 8 * w4 + (lane >> 3), pc = lane & 7, lc = pc ^ ((row >> 1) & 7);
          src = (wid < 4 ? K : V) + (size_t)(row * d + r) * HD + lc * 8; tstride = (size_t)32 * d * HD; dstoff = (wid < 4 ? 0 : 4096) + w4 * 1024; }
#pragma unroll
        for (int j = 0; j < 12; ++j) { const int jt = ib0 - 4 + j;
            if (jt >= 0) __builtin_amdgcn_global_load_lds((const unsigned*)(src + (size_t)jt * tstride), (LAS unsigned*)(lds + j * 8192 + dstoff), 16, 0, 0); }
    }
    const int iq = 32 * ib + i32, tq = iq * d + r;
    bf16x8 qf[4];
#pragma unroll
    for (int kk = 0; kk < 4; ++kk) qf[kk] = *(const bf16x8*)(Q + (size_t)tq * HD + 16 * kk + 8 * hi);
    int koff[4], toff[2][2][2];
    { const int rho = kvmap(i32);
#pragma unroll
      for (int kk = 0; kk < 4; ++kk) koff[kk] = rho * 128 + (((2 * kk + hi) ^ ((rho >> 1) & 7)) << 4); }
    tr_offsets(lane, toff);
    asm volatile("s_waitcnt vmcnt(0)\n\ts_barrier" ::: "memory");
    FA2 st; fa2_init(st);
#pragma unroll 1
    for (int jj = 0; jj < 5; ++jj) {
        const int jt = ib - 4 + jj;
        if (jt < 0) continue;
        const LAS unsigned char* stg = lds + (wid + jj) * 8192;
        bf16x8 kf[4], vf[2][2];
#pragma unroll
        for (int kk = 0; kk < 4; ++kk) kf[kk] = *(const LAS bf16x8*)(stg + koff[kk]);
        read_v_tr(stg + 4096, toff, vf);
        const bool nm = (jj == 0 || jj == 4);
        unsigned vm = 0xffffu;
        if (nm) { vm = 0;
#pragma unroll
            for (int rr = 0; rr < 16; ++rr) { const int ik = 32 * jt + kvl_of(rr, hi); vm |= ((ik <= iq) && (iq - ik <= 128)) ? (1u << rr) : 0u; } }
        fa2_step(st, kf, vf, qf, true, nm, vm);
    }
    const float l = st.l + __shfl_xor(st.l, 32);
    const int b = bh >> 3, h = bh & 7;
    const size_t tok = (size_t)b * SEQ + tq;
    store_o((bf16_t*)(ws + WS_OP) + ((size_t)p * MROWS + tok) * 512 + h * HD, st.o0, st.o1, 1.0f / l, hi);
    if (hi == 0) ((float*)(ws + WS_LSE))[((size_t)p * MROWS + tok) * 8 + h] = LN2F * (st.mref + __log2f(l));
    asm volatile("s_waitcnt lgkmcnt(0)\n\ts_barrier" ::: "memory");
}

constexpr int NSA_RING = 0, NSA_NS = 16, NSA_D = 8, NSA_UW = 140 * 1024;
DI void nsa_unit(unsigned char* ws, LAS unsigned char* lds, int unit) {
    int tid = threadIdx.x; asm volatile("" : "+v"(tid));
    const int lane = tid & 63, wid = __builtin_amdgcn_readfirstlane(tid >> 6), i32 = lane & 31, hi = lane >> 5;
    const int qt = 127 - (unit >> 3), bg = unit & 7, b = bg >> 1, g = bg & 1;
    LAS float* impA = (LAS float*)lds; LAS float* impC = impA + 64 * 128; LAS unsigned short* sel16 = (LAS unsigned short*)(impC + 64 * 128);
    const int ql = 8 * wid + (i32 >> 2), hh = i32 & 3, t = 64 * qt + ql, head = g * 4 + hh;
    bf16x8 qf[4];
    { const bf16_t* Q = (const bf16_t*)(ws + WS_QB) + ((size_t)(b * NHB + head) * SEQ + t) * HD;
#pragma unroll
      for (int kk = 0; kk < 4; ++kk) qf[kk] = *(const bf16x8*)(Q + 16 * kk + 8 * hi); }
    const float* gp = (const float*)(ws + WS_GATES) + ((size_t)b * SEQ + t) * 24 + head * 3;
    const float g_cmp = gp[0], g_slc = gp[1], g_win = gp[2];
    f32x16 a0, a1;
#pragma unroll
    for (int r = 0; r < 16; ++r) { a0[r] = 0.f; a1[r] = 0.f; }
    const int t_lo_w = 64 * qt + 8 * wid, t_hi_w = t_lo_w + 7;
    const bf16_t* KCC = (const bf16_t*)(ws + WS_KCC) + (size_t)bg * NCP * HD;
    const bf16_t* VCCT = (const bf16_t*)(ws + WS_VCCT) + (size_t)bg * HD * NCP;
    const int nvis = t >= 31 ? ((t - 31) >> 4) + 1 : 0;
    const int nvis_w = t_hi_w >= 31 ? ((t_hi_w - 31) >> 4) + 1 : 0, ntile = (nvis_w + 31) >> 5;
    const int nvis_lo = t_lo_w >= 31 ? ((t_lo_w - 31) >> 4) + 1 : 0;
    float mc, invc;
    int koff[4], voff[2][2];
    { const int rho = kvmap(i32);
#pragma unroll
      for (int kk = 0; kk < 4; ++kk) koff[kk] = rho * 128 + (((2 * kk + hi) ^ ((rho >> 1) & 7)) << 4);
#pragma unroll
      for (int db = 0; db < 2; ++db)
#pragma unroll
          for (int ks = 0; ks < 2; ++ks) { const int row = 32 * db + i32; voff[db][ks] = row * 64 + (((2 * ks + hi) ^ ((row >> 2) & 3)) << 4); } }
    unsigned srcoff, dstoff;
    if (wid < 4) { const int row = 8 * wid + (lane >> 3), pc = lane & 7, lc = pc ^ ((row >> 1) & 7); srcoff = row * 64 + lc * 8; dstoff = wid * 1024; }
    else { const int v = wid - 4, row = 16 * v + (lane >> 2), pc = lane & 3, lc = pc ^ ((row >> 2) & 3); srcoff = row * 32 + lc * 8; dstoff = (wid - 4) * 1024; }
    {
        const int t_hi_b = 64 * qt + 63, nvis_b = t_hi_b >= 31 ? ((t_hi_b - 31) >> 4) + 1 : 0, ntile_b = (nvis_b + 31) >> 5;
        const bf16_t* cbase = (wid < 4 ? KCC : VCCT) + srcoff; const unsigned cdst = (wid < 4 ? 65536u : 0u) + dstoff;
#pragma unroll 1
        for (int j = 0; j < ntile_b; ++j) __builtin_amdgcn_global_load_lds((const unsigned*)(cbase + (size_t)j * 2048), (LAS unsigned*)(lds + cdst + j * 4096), 16, 0, 0);
        asm volatile("s_waitcnt vmcnt(0)\n\ts_barrier" ::: "memory");
        FA2 st; fa2_init(st);
#pragma unroll 1
        for (int jt = 0; jt < ntile; ++jt) {
            bf16x8 kf[4], vf[2][2];
#pragma unroll
            for (int kk = 0; kk < 4; ++kk) kf[kk] = *(const LAS bf16x8*)(lds + 65536 + jt * 4096 + koff[kk]);
#pragma unroll
            for (int db = 0; db < 2; ++db)
#pragma unroll
                for (int ks = 0; ks < 2; ++ks) vf[db][ks] = *(const LAS bf16x8*)(lds + jt * 4096 + voff[db][ks]);
            const bool nm = 32 * jt + 32 > nvis_lo; unsigned vm = 0xffffu;
            if (nm) { vm = 0;
#pragma unroll
                for (int rr = 0; rr < 16; ++rr) vm |= (32 * jt + kvl_of(rr, hi) < nvis) ? (1u << rr) : 0u; }
            fa2_step(st, kf, vf, qf, true, nm, vm);
        }
        const float l = st.l + __shfl_xor(st.l, 32);
        invc = l > 0.f ? 1.0f / l : 0.f; mc = st.mref;
        const float sc = g_cmp * invc;
#pragma unroll
        for (int r = 0; r < 16; ++r) { a0[r] += sc * st.o0[r]; a1[r] += sc * st.o1[r]; }
    }
    asm volatile("s_waitcnt lgkmcnt(0)\n\ts_barrier" ::: "memory");
#pragma unroll
    for (int k = 0; k < 16; ++k) { impA[(8 * wid) * 128 + lane + 64 * k] = 0.f; impC[(8 * wid) * 128 + lane + 64 * k] = 0.f; }
    {
        const f32x16 cm = splat16(-mc);
#pragma unroll 1
        for (int jt = 0; jt < ntile; ++jt) {
            bf16x8 kf[4];
#pragma unroll
            for (int kk = 0; kk < 4; ++kk) kf[kk] = *(const LAS bf16x8*)(lds + 65536 + jt * 4096 + koff[kk]);
            f32x16 s = MFMA32(kf[0], qf[0], cm);
            s = MFMA32(kf[1], qf[1], s); s = MFMA32(kf[2], qf[2], s); s = MFMA32(kf[3], qf[3], s);
#pragma unroll
            for (int rr = 0; rr < 16; ++rr) {
                float p = (32 * jt + kvl_of(rr, hi) < nvis) ? __builtin_amdgcn_exp2f(s[rr]) * invc : 0.f;
                p += dppf<0xB1>(p); p += dppf<0x4E>(p);
                s[rr] = p;
            }
            if (hh == 0) {
#pragma unroll
                for (int grp = 0; grp < 4; ++grp) {
                    const int r0 = 4 * grp, sb = 8 * jt + 4 * (r0 >> 3) + 2 * hi + ((r0 & 7) >> 2);
                    impA[ql * 128 + sb] = s[r0] + s[r0 + 1] + s[r0 + 2] + 0.5f * s[r0 + 3];
                    impC[ql * 128 + sb] = 0.5f * s[r0 + 3];
                }
            }
        }
    }
    __syncthreads();
    {
        const int q2 = tid >> 3, part = tid & 7;
        unsigned key[16];
#pragma unroll
        for (int k = 0; k < 16; ++k) {
            const int s = 16 * part + k;
            const bool forced = (s == qt) || (s == qt - 1) || (s == 0);
            const bool valid = s <= qt;
            const float imp = impA[q2 * 128 + s] + (s > 0 ? impC[q2 * 128 + s - 1] : 0.f);
            const float scv = forced ? 1e9f : (valid ? imp : -1e9f);
            const unsigned ub = __builtin_bit_cast(unsigned, scv);
            key[k] = (ub & 0x80000000u) ? ~ub : (ub | 0x80000000u);
        }
        unsigned thr = 0u;
#pragma unroll 1
        for (int bit = 31; bit >= 0; --bit) {
            const unsigned cand = thr | (1u << bit);
            int c = 0;
#pragma unroll
            for (int k = 0; k < 16; ++k) c += (key[k] >= cand) ? 1 : 0;
            c = sum8(c);
            if (c >= 16) thr = cand;
        }
        int ngt = 0, neq = 0;
#pragma unroll
        for (int k = 0; k < 16; ++k) { ngt += (key[k] > thr) ? 1 : 0; neq += (key[k] == thr) ? 1 : 0; }
        int tg = sum8(ngt);
        int incl = neq;
        { int v = __shfl_up(incl, 1); if (part >= 1) incl += v; v = __shfl_up(incl, 2); if (part >= 2) incl += v; v = __shfl_up(incl, 4); if (part >= 4) incl += v; }
        int eq_before = incl - neq;
        const int quota = 16 - tg;
        unsigned bits = 0;
#pragma unroll
        for (int k = 0; k < 16; ++k) {
            bool take = key[k] > thr;
            if (key[k] == thr) { take = eq_before < quota; ++eq_before; }
            bits |= (take && (16 * part + k) <= qt) ? (1u << k) : 0u;
        }
        sel16[q2 * 8 + part] = (unsigned short)bits;
    }
    __syncthreads();
    {
        const LAS unsigned* selw = (const LAS unsigned*)sel16 + ql * 4;
        const unsigned s0 = selw[0], s1 = selw[1], s2 = selw[2], s3 = selw[3];
        __syncthreads();
        const bf16_t* KS = (const bf16_t*)(ws + WS_KS) + (size_t)bg * SEQ * HD;
        const bf16_t* VST = (const bf16_t*)(ws + WS_VST) + (size_t)bg * SEQ * HD;
        const bf16_t* KW = (const bf16_t*)(ws + WS_KW) + (size_t)bg * SEQ * HD;
        const bf16_t* VWT = (const bf16_t*)(ws + WS_VWT) + (size_t)bg * SEQ * HD;
        const int T_s = 2 * qt + 2;
        const int w_lo = (64 * qt - 512 < 0 ? 0 : 64 * qt - 512) >> 5, T_w = 2 * qt + 2 - w_lo, T = T_s + T_w;
        unsigned rsrc, rdst;
        { const int w4 = wid & 3, row = 8 * w4 + (lane >> 3), pc = lane & 7, lc = pc ^ ((row >> 1) & 7); rsrc = row * 64 + lc * 8; rdst = (wid < 4 ? 0u : 4096u) + w4 * 1024; }
        int toff[2][2][2]; tr_offsets(lane, toff);
        const bf16_t* base_s = (wid < 4) ? KS : VST; const bf16_t* base_w = (wid < 4) ? KW : VWT;
#define NSA_ISSUE(n_) do { const int n__ = (n_); const bool isw__ = n__ >= T_s; const int tile__ = isw__ ? (w_lo + n__ - T_s) : n__; \
            const bf16_t* src__ = (isw__ ? base_w : base_s) + (size_t)tile__ * 2048 + rsrc; \
            __builtin_amdgcn_global_load_lds((const unsigned*)src__, (LAS unsigned*)(lds + NSA_RING + (n__ & (NSA_NS - 1)) * 8192 + rdst), 16, 0, 0); } while (0)
#pragma unroll
        for (int n = 0; n < NSA_D; ++n) if (n < T) NSA_ISSUE(n);
        FA2 st; fa2_init(st);
        bool sel = true;
#pragma unroll 1
        for (int n = 0; n < T; n += 8) {
            const int after = 0;
            if (after >= 8) asm volatile("s_waitcnt vmcnt(8)" ::: "memory");
            else if (after == 6) asm volatile("s_waitcnt vmcnt(6)" ::: "memory");
            else if (after == 4) asm volatile("s_waitcnt vmcnt(4)" ::: "memory");
            else if (after == 2) asm volatile("s_waitcnt vmcnt(2)" ::: "memory");
            else asm volatile("s_waitcnt vmcnt(0)" ::: "memory");
            asm volatile("s_barrier" ::: "memory");
#pragma unroll
            for (int k = 0; k < 8; ++k) if (n + NSA_D + k < T) NSA_ISSUE(n + NSA_D + k);
#pragma unroll 1
            for (int np = n; np < n + 8 && np < T; np += 2) {
                if (np == T_s) {
                    const float l = st.l + __shfl_xor(st.l, 32);
                    const float sc = g_slc / l;
#pragma unroll
                    for (int r = 0; r < 16; ++r) { a0[r] += sc * st.o0[r]; a1[r] += sc * st.o1[r]; }
                    fa2_init(st); sel = true;
                }
                bool active = true;
                if (np < T_s) {
                    const int jb = np >> 1;
                    const unsigned w = jb < 32 ? s0 : (jb < 64 ? s1 : (jb < 96 ? s2 : s3));
                    sel = (w >> (jb & 31)) & 1u;
                    active = __any(sel);
                }
                if (active) {
                    const LAS unsigned char* sgA = lds + NSA_RING + (np & (NSA_NS - 1)) * 8192;
                    const LAS unsigned char* sgB = lds + NSA_RING + ((np + 1) & (NSA_NS - 1)) * 8192;
                    bf16x8 kA[4], kB[4];
#pragma unroll
                    for (int kk = 0; kk < 4; ++kk) { kA[kk] = *(const LAS bf16x8*)(sgA + koff[kk]); kB[kk] = *(const LAS bf16x8*)(sgB + koff[kk]); }
                    bool nmA, nmB; unsigned vmA = 0xffffu, vmB = 0xffffu;
                    if (np < T_s) {
                        nmA = nmB = (np >> 1) == qt;
                        if (nmA) { vmA = 0; vmB = 0;
#pragma unroll
                            for (int rr = 0; rr < 16; ++rr) { vmA |= (32 * np + kvl_of(rr, hi) <= t) ? (1u << rr) : 0u; vmB |= (32 * np + 32 + kvl_of(rr, hi) <= t) ? (1u << rr) : 0u; } }
                    } else {
                        const int kv0 = 32 * (w_lo + np - T_s);
                        nmA = !(kv0 >= t_hi_w - 511 && kv0 + 31 <= t_lo_w);
                        nmB = !(kv0 + 32 >= t_hi_w - 511 && kv0 + 63 <= t_lo_w);
                        if (nmA) { vmA = 0;
#pragma unroll
                            for (int rr = 0; rr < 16; ++rr) { const int k = kv0 + kvl_of(rr, hi); vmA |= ((k <= t) && (t - k < 512)) ? (1u << rr) : 0u; } }
                        if (nmB) { vmB = 0;
#pragma unroll
                            for (int rr = 0; rr < 16; ++rr) { const int k = kv0 + 32 + kvl_of(rr, hi); vmB |= ((k <= t) && (t - k < 512)) ? (1u << rr) : 0u; } }
                    }
                    fa2_pair_latev(st, kA, sgA + 4096, kB, sgB + 4096, toff, qf, sel, nmA, vmA, nmB, vmB);
                }
            }
        }
        const float l = st.l + __shfl_xor(st.l, 32);
        const float sc = g_win / l;
#pragma unroll
        for (int r = 0; r < 16; ++r) { a0[r] += sc * st.o0[r]; a1[r] += sc * st.o1[r]; }
    }
    store_o((bf16_t*)(ws + WS_CAT) + ((size_t)b * SEQ + t) * DM + 512 + head * HD, a0, a1, 1.0f, hi);
}

struct Args { const float* in[19]; float* out; unsigned char* ws; };
enum { I_X = 0, I_C, I_WADA, I_BADA, I_WIN, I_PE, I_WCK1, I_WCK2, I_WCV1, I_WCV2, I_WO, I_LN1G, I_LN1B, I_WUP, I_CONVW, I_CONVB, I_WDOWN, I_LN2G, I_LN2B };

template <int MODE> DI int maprow(int n) { if (MODE == 1) { return n < FF ? 256 * (n >> 7) + (n & 127) : 256 * ((n - FF) >> 7) + 128 + ((n - FF) & 127); } return n; }
template <int MODE> DI void tr_item(const float* W, int K, int N, bf16_t* WT, LAS float* scr, int item, int lane) {
    const int nblk = (N + 31) / 32, kb = item / nblk, nb = item % nblk, k0 = 64 * kb, n0 = 32 * nb;
    const int nn = n0 + (lane & 31);
#pragma unroll
    for (int i = 0; i < 32; ++i) { const int kk = 2 * i + (lane >> 5); scr[kk * 33 + (lane & 31)] = nn < N ? W[(size_t)(k0 + kk) * N + nn] : 0.f; }
    asm volatile("s_waitcnt lgkmcnt(0)" ::: "memory");
    const int c = lane & 7;
#pragma unroll
    for (int j = 0; j < 4; ++j) { const int nl = (lane >> 3) + 8 * j, n = n0 + nl; const LAS float* s = scr + (8 * c) * 33 + nl;
        u32x4 o; o.x = pk2(s[0 * 33], s[1 * 33]); o.y = pk2(s[2 * 33], s[3 * 33]); o.z = pk2(s[4 * 33], s[5 * 33]); o.w = pk2(s[6 * 33], s[7 * 33]);
        if (n < N) *(u32x4*)(WT + (size_t)maprow<MODE>(n) * K + k0 + 8 * c) = o; }
    asm volatile("s_waitcnt lgkmcnt(0)" ::: "memory");
}
template <int MODE> DI void tr_matrix(const float* W, int K, int N, bf16_t* WT, LAS float* scr, int gw, int ngw, int lane) {
    const int nitems = (K / 64) * ((N + 31) / 32);
    for (int it = gw; it < nitems; it += ngw) tr_item<MODE>(W, K, N, WT, scr, it, lane);
}

DI void phase0(const Args& a, LAS unsigned char* lds) {
    unsigned char* ws = a.ws;
    const int tid = threadIdx.x, lane = tid & 63, wid = tid >> 6, G = gridDim.x, bx = blockIdx.x;
    if (bx == 0 && tid < 16) ((unsigned*)(ws + WS_CTR))[tid] = 0u;
    if (bx == 0) for (int i = tid; i < 3456; i += 512) ((unsigned*)(ws + WS_BAR))[i] = 0u;
    {
        LAS float* red = (LAS float*)lds;
        const float* c = a.in[I_C]; const float* W = a.in[I_WADA];
        LAS float* sl = (LAS float*)(lds + 16384);
        if (bx < 192) { for (int i = tid; i < 4096; i += 512) { const float cv = c[i]; sl[i] = cv / (1.f + __expf(-cv)); } __syncthreads(); }
        for (int it = bx; it < 192; it += G) {
            const int col = it * 32 + (tid & 31), kc = tid >> 5;
            float s0 = 0.f, s1 = 0.f, s2 = 0.f, s3 = 0.f;
#pragma unroll 16
            for (int k = kc * 64; k < kc * 64 + 64; ++k) {
                const float w = W[(size_t)k * 6144 + col];
                s0 += w * sl[k]; s1 += w * sl[1024 + k]; s2 += w * sl[2048 + k]; s3 += w * sl[3072 + k];
            }
            red[(kc * 4 + 0) * 32 + (tid & 31)] = s0; red[(kc * 4 + 1) * 32 + (tid & 31)] = s1; red[(kc * 4 + 2) * 32 + (tid & 31)] = s2; red[(kc * 4 + 3) * 32 + (tid & 31)] = s3;
            __syncthreads();
            if (tid < 128) { const int bb = tid >> 5, cc = tid & 31; float s = 0.f;
#pragma unroll
                for (int k = 0; k < 16; ++k) s += red[(k * 4 + bb) * 32 + cc];
                ((float*)(ws + WS_MOD))[bb * 6144 + it * 32 + cc] = s + a.in[I_BADA][it * 32 + cc]; }
            __syncthreads();
        }
        for (int it = (G >= 208 ? bx - 192 : bx); it >= 0 && it < 16; it += G) {
            const int z = it >> 3, col = (it & 7) * 32 + (tid & 31), kc = tid >> 5;
            const float* W1 = a.in[z ? I_WCV1 : I_WCK1]; const float* pe = a.in[I_PE];
            float s = 0.f;
#pragma unroll 32
            for (int k = kc * 128; k < kc * 128 + 128; ++k) s += pe[k] * W1[(size_t)k * 256 + col];
            red[kc * 32 + (tid & 31)] = s;
            __syncthreads();
            if (tid < 32) { float t = 0.f;
#pragma unroll
                for (int k = 0; k < 16; ++k) t += red[k * 32 + tid];
                ((float*)(ws + WS_CB))[z * 256 + (it & 7) * 32 + tid] = t; }
            __syncthreads();
        }
    }
    for (int idx = bx * 512 + tid; idx < SEQ * 8; idx += G * 512) {
        const int pos = idx >> 3, i = idx & 7;
        const double inv = exp(-log(500000.0) * (double)i / 8.0);
        const float ang = (float)pos * (float)inv;
        double sn, cs; sincos((double)ang, &sn, &cs);
        ((f32x2*)(ws + WS_ROPE))[idx] = (f32x2){(float)cs, (float)sn};
    }
    {
        LAS float* scr = (LAS float*)(lds + 8192) + wid * (64 * 33);
        const int gw = bx * 8 + wid, ngw = G * 8;
        tr_matrix<0>(a.in[I_WIN], DM, NIN, (bf16_t*)(ws + WS_WIN), scr, gw, ngw, lane);
        tr_matrix<0>(a.in[I_WO], DM, DM, (bf16_t*)(ws + WS_WO), scr, gw, ngw, lane);
        tr_matrix<1>(a.in[I_WUP], DM, NUP, (bf16_t*)(ws + WS_WUP), scr, gw, ngw, lane);
        tr_matrix<0>(a.in[I_WDOWN], FF, DM, (bf16_t*)(ws + WS_WDN), scr, gw, ngw, lane);
        tr_matrix<0>(a.in[I_WCK1], 2048, 256, (bf16_t*)(ws + WS_WC1), scr, gw, ngw, lane);
        tr_matrix<0>(a.in[I_WCV1], 2048, 256, (bf16_t*)(ws + WS_WC1) + 256 * 2048, scr, gw, ngw, lane);
        tr_matrix<0>(a.in[I_WCK2], 256, 64, (bf16_t*)(ws + WS_W2C), scr, gw, ngw, lane);
        tr_matrix<0>(a.in[I_WCV2], 256, 64, (bf16_t*)(ws + WS_W2C) + 64 * 256, scr, gw, ngw, lane);
        u32x4* z = (u32x4*)((bf16_t*)(ws + WS_WIN) + (size_t)NIN * DM);
        const int nz = (NINP - NIN) * DM / 8;
        for (int i = bx * 512 + tid; i < nz; i += G * 512) z[i] = (u32x4){0u, 0u, 0u, 0u};
    }
}

DI void row_load(const float* p, int lane, f32x4 (&v)[4]) {
#pragma unroll
    for (int j = 0; j < 4; ++j) v[j] = *(const f32x4*)(p + 4 * lane + 256 * j);
}
DI void row_load_nt(const float* p, int lane, f32x4 (&v)[4]) {
#pragma unroll
    for (int j = 0; j < 4; ++j) v[j] = __builtin_nontemporal_load((const f32x4*)(p + 4 * lane + 256 * j));
}
DI void row_norm(f32x4 (&v)[4]) {
    float s = 0.f;
#pragma unroll
    for (int j = 0; j < 4; ++j) s += (v[j].x + v[j].y) + (v[j].z + v[j].w);
    const float mean = wave_sum(s) * (1.f / DM); float s2 = 0.f;
#pragma unroll
    for (int j = 0; j < 4; ++j) { v[j] = v[j] - mean; s2 += (v[j].x * v[j].x + v[j].y * v[j].y) + (v[j].z * v[j].z + v[j].w * v[j].w); }
    const float rstd = 1.f / sqrtf(wave_sum(s2) * (1.f / DM) + LN_EPS);
#pragma unroll
    for (int j = 0; j < 4; ++j) v[j] = v[j] * rstd;
}
DI void row_mod_store(const f32x4 (&v)[4], const float* sh, const float* sc, bf16_t* o, int lane) {
#pragma unroll
    for (int j = 0; j < 4; ++j) { const f32x4 a = *(const f32x4*)(sc + 4 * lane + 256 * j), b = *(const f32x4*)(sh + 4 * lane + 256 * j);
        const f32x4 r = v[j] * (a + 1.0f) + b; u32x2 w; w.x = pk2(r.x, r.y); w.y = pk2(r.z, r.w); *(u32x2*)(o + 4 * lane + 256 * j) = w; }
}
DI void phase1(const Args& a) {
    const int lane = threadIdx.x & 63, gw = blockIdx.x * 8 + (threadIdx.x >> 6), ngw = gridDim.x * 8;
    const float* mod = (const float*)(a.ws + WS_MOD);
    for (int m0 = gw; m0 < MROWS; m0 += 4 * ngw) {
        f32x4 v[4][4]; bool has[4]; int mr[4];
#pragma unroll
        for (int k = 0; k < 4; ++k) { const int m = m0 + k * ngw; has[k] = m < MROWS; mr[k] = has[k] ? m : m0; row_load_nt(a.in[I_X] + (size_t)mr[k] * DM, lane, v[k]); }
#pragma unroll
        for (int k = 0; k < 4; ++k) row_norm(v[k]);
#pragma unroll
        for (int k = 0; k < 4; ++k) if (has[k]) { const int b = mr[k] >> 13; row_mod_store(v[k], mod + b * 6144 + 0 * 1024, mod + b * 6144 + 1 * 1024, (bf16_t*)(a.ws + WS_U) + (size_t)mr[k] * DM, lane); }
    }
}
DI void row_load_bf16(const bf16_t* p, int lane, f32x4 (&v)[4]) {
#pragma unroll
    for (int j = 0; j < 4; ++j) { const u32x2 w = __builtin_nontemporal_load((const u32x2*)(p + 4 * lane + 256 * j));
        v[j] = (f32x4){bf2f((unsigned short)(w.x & 0xffffu)), bf2f((unsigned short)(w.x >> 16)), bf2f((unsigned short)(w.y & 0xffffu)), bf2f((unsigned short)(w.y >> 16))}; }
}
DI void phase5b(const Args& a) {
    const int lane = threadIdx.x & 63, gw = blockIdx.x * 8 + (threadIdx.x >> 6), ngw = gridDim.x * 8;
    const float* mod = (const float*)(a.ws + WS_MOD); const bf16_t* Y = (const bf16_t*)(a.ws + WS_OP);
    f32x4 gg[4], bb[4]; row_load(a.in[I_LN1G], lane, gg); row_load(a.in[I_LN1B], lane, bb);
    for (int m0 = gw; m0 < MROWS; m0 += 4 * ngw) {
        f32x4 v[4][4]; bool has[4]; int mr[4];
#pragma unroll
        for (int k = 0; k < 4; ++k) { const int m = m0 + k * ngw; has[k] = m < MROWS; mr[k] = has[k] ? m : m0; row_load_nt(a.in[I_X] + (size_t)mr[k] * DM, lane, v[k]); }
#pragma unroll
        for (int k = 0; k < 4; ++k) { f32x4 y[4], g1[4]; row_load_bf16(Y + (size_t)mr[k] * DM, lane, y); row_load(mod + (mr[k] >> 13) * 6144 + 2 * 1024, lane, g1);
#pragma unroll
            for (int j = 0; j < 4; ++j) v[k][j] = v[k][j] * ALPHA + g1[j] * y[j]; }
#pragma unroll
        for (int k = 0; k < 4; ++k) row_norm(v[k]);
#pragma unroll
        for (int k = 0; k < 4; ++k) { float* p = a.out + (size_t)mr[k] * DM;
#pragma unroll
            for (int j = 0; j < 4; ++j) { v[k][j] = v[k][j] * gg[j] + bb[j]; if (has[k]) __builtin_nontemporal_store(v[k][j], (f32x4*)(p + 4 * lane + 256 * j)); } }
#pragma unroll
        for (int k = 0; k < 4; ++k) row_norm(v[k]);
#pragma unroll
        for (int k = 0; k < 4; ++k) if (has[k]) { const int b = mr[k] >> 13; row_mod_store(v[k], mod + b * 6144 + 3 * 1024, mod + b * 6144 + 4 * 1024, (bf16_t*)(a.ws + WS_U) + (size_t)mr[k] * DM, lane); }
    }
}
DI void phase7b(const Args& a) {
    const int lane = threadIdx.x & 63, gw = blockIdx.x * 8 + (threadIdx.x >> 6), ngw = gridDim.x * 8;
    const float* mod = (const float*)(a.ws + WS_MOD); const bf16_t* Z = (const bf16_t*)(a.ws + WS_U);
    f32x4 gg[4], bb[4]; row_load(a.in[I_LN2G], lane, gg); row_load(a.in[I_LN2B], lane, bb);
    for (int m0 = gw; m0 < MROWS; m0 += 4 * ngw) {
        f32x4 v[4][4]; bool has[4]; int mr[4];
#pragma unroll
        for (int k = 0; k < 4; ++k) { const int m = m0 + k * ngw; has[k] = m < MROWS; mr[k] = has[k] ? m : m0; row_load_nt(a.out + (size_t)mr[k] * DM, lane, v[k]); }
#pragma unroll
        for (int k = 0; k < 4; ++k) { f32x4 y[4], g2[4]; row_load_bf16(Z + (size_t)mr[k] * DM, lane, y); row_load(mod + (mr[k] >> 13) * 6144 + 5 * 1024, lane, g2);
#pragma unroll
            for (int j = 0; j < 4; ++j) v[k][j] = v[k][j] * ALPHA + g2[j] * y[j]; }
#pragma unroll
        for (int k = 0; k < 4; ++k) row_norm(v[k]);
#pragma unroll
        for (int k = 0; k < 4; ++k) if (has[k]) { float* p = a.out + (size_t)mr[k] * DM;
#pragma unroll
            for (int j = 0; j < 4; ++j) __builtin_nontemporal_store(v[k][j] * gg[j] + bb[j], (f32x4*)(p + 4 * lane + 256 * j)); }
    }
}

DI void compress_unit(const Args& a, LAS unsigned char* lds, int cu) {
    unsigned char* ws = a.ws;
    const int z = cu >> 4, pm = cu & 15;
    bf16_t* HID = (bf16_t*)(ws + WS_HID) + (size_t)z * 4096 * 256;
    {
        pg8::Gemm g{(const bf16_t*)(ws + (z ? WS_VC : WS_KC)), (const bf16_t*)(ws + WS_WC1) + (size_t)z * 256 * 2048, 4096, 256, 2048, 1024};
        pg8::OneUnit S{pm};
        EpiHid E{HID, (const float*)(ws + WS_CB) + z * 256};
        pg8::gemm_phase<EpiHid, pg8::OneUnit>(lds, g, S, E);
    }
    __threadfence(); __syncthreads();
    const int tid = threadIdx.x, lane = tid & 63, wid = tid >> 6, i32 = lane & 31, hi = lane >> 5;
    const int row = pm * 256 + wid * 32 + i32;
    const bf16_t* W2T = (const bf16_t*)(ws + WS_W2C) + (size_t)z * 64 * 256;
    f32x16 o0, o1;
#pragma unroll
    for (int r = 0; r < 16; ++r) { o0[r] = 0.f; o1[r] = 0.f; }
#pragma unroll 4
    for (int ks = 0; ks < 16; ++ks) {
        const bf16x8 bf = *(const bf16x8*)(HID + (size_t)row * 256 + 16 * ks + 8 * hi);
        const bf16x8 w0 = *(const bf16x8*)(W2T + (size_t)i32 * 256 + 16 * ks + 8 * hi);
        const bf16x8 w1 = *(const bf16x8*)(W2T + (size_t)(32 + i32) * 256 + 16 * ks + 8 * hi);
        o0 = MFMA32(w0, bf, o0); o1 = MFMA32(w1, bf, o1);
    }
    const int bg = row >> 9, n = row & 511;
    if (z == 0) {
        store_o((bf16_t*)(ws + WS_KCC) + ((size_t)bg * NCP + n) * HD, o0, o1, 1.0f, hi);
    } else {
        bf16_t* vt = (bf16_t*)(ws + WS_VCCT) + (size_t)bg * HD * NCP + (size_t)(n >> 5) * 2048 + (n & 31);
#pragma unroll
        for (int r = 0; r < 16; ++r) { const int d = (r & 3) + 8 * (r >> 2) + 4 * hi; vt[d * 32] = (bf16_t)f2bf(o0[r]); vt[(32 + d) * 32] = (bf16_t)f2bf(o1[r]); }
    }
    __syncthreads();
}

DI void phase3(const Args& a, LAS unsigned char* lds, int cidx = 0) {
    for (int cu = blockIdx.x; cu < 32; cu += gridDim.x) compress_unit(a, lds, cu);
    unsigned* ctr = (unsigned*)(a.ws + WS_CTR) + cidx;
    LAS unsigned* uw = (LAS unsigned*)(lds + 100 * 1024);
    if (threadIdx.x == 0) uw[0] = atomicAdd(ctr, 1u);
    __syncthreads();
    for (;;) {
        const unsigned u = uw[0];
        __syncthreads();
        if (u >= 3072u) break;
        if (threadIdx.x == 0) uw[0] = atomicAdd(ctr, 1u);
        dilated_block_unit(a.ws, lds, (int)u);
    }
}

DI void phase4(const Args& a, LAS unsigned char* lds, int cidx = 1) {
    unsigned* ctr = (unsigned*)(a.ws + WS_CTR) + cidx;
    LAS unsigned* uw = (LAS unsigned*)(lds + NSA_UW);
    if (gridDim.x == 256) {
        const int bg = blockIdx.x & 7, j = blockIdx.x >> 3;
#pragma unroll 1
        for (int i = 0; i < 4; ++i) {
            const int qt = (i == 0) ? 127 - j : (i == 1) ? 64 + j : (i == 2) ? 63 - j : j;
            nsa_unit(a.ws, lds, (127 - qt) * 8 + bg);
            __syncthreads();
        }
    } else
    for (;;) {
        if (threadIdx.x == 0) uw[0] = atomicAdd(ctr, 1u);
        __syncthreads();
        const unsigned u = uw[0];
        __syncthreads();
        if (u >= 1024u) break;
        nsa_unit(a.ws, lds, (int)u);
    }
    const int lane = threadIdx.x & 63, gw = blockIdx.x * 8 + (threadIdx.x >> 6), ngw = gridDim.x * 8;
    const float* LSE = (const float*)(a.ws + WS_LSE); const bf16_t* OP = (const bf16_t*)(a.ws + WS_OP); bf16_t* CAT = (bf16_t*)(a.ws + WS_CAT);
    for (int tok = gw; tok < MROWS; tok += ngw) {
        const int h = lane >> 3;
        const float l0 = LSE[(size_t)tok * 8 + h], l1 = LSE[((size_t)MROWS + tok) * 8 + h], l2 = LSE[((size_t)2 * MROWS + tok) * 8 + h];
        const float mx = fmaxf(l0, fmaxf(l1, l2));
        float w0 = __expf(l0 - mx), w1 = __expf(l1 - mx), w2 = __expf(l2 - mx); const float inv = 1.f / (w0 + w1 + w2); w0 *= inv; w1 *= inv; w2 *= inv;
        const u32x4 x0 = __builtin_nontemporal_load((const u32x4*)(OP + (size_t)tok * 512 + 8 * lane)), x1 = __builtin_nontemporal_load((const u32x4*)(OP + ((size_t)MROWS + tok) * 512 + 8 * lane)), x2 = __builtin_nontemporal_load((const u32x4*)(OP + ((size_t)2 * MROWS + tok) * 512 + 8 * lane));
        u32x4 o;
#pragma unroll
        for (int k = 0; k < 4; ++k) {
            const float lo = w0 * bf2f((unsigned short)(x0[k] & 0xffffu)) + w1 * bf2f((unsigned short)(x1[k] & 0xffffu)) + w2 * bf2f((unsigned short)(x2[k] & 0xffffu));
            const float hi = w0 * bf2f((unsigned short)(x0[k] >> 16)) + w1 * bf2f((unsigned short)(x1[k] >> 16)) + w2 * bf2f((unsigned short)(x2[k] >> 16));
            o[k] = pk2(lo, hi);
        }
        *(u32x4*)(CAT + (size_t)tok * DM + 8 * lane) = o;
    }
}

DI void phase6b(const Args& a) {
    const float* edge = (const float*)(a.ws + WS_EDGE); const float* fixg = (const float*)(a.ws + WS_FIXG); const float* fixv = (const float*)(a.ws + WS_FIXV);
    const float* cw = a.in[I_CONVW]; bf16_t* H = (bf16_t*)(a.ws + WS_H);
    const int total = 128 * 2 * FF;
    for (int idx = blockIdx.x * 512 + threadIdx.x; idx < total; idx += gridDim.x * 512) {
        const int f = idx % FF, rr = (idx / FF) & 1, pm = idx / (2 * FF);
        if ((pm & 31) == 0) continue;
        float gpre = fixg[((size_t)pm * 2 + rr) * FF + f];
        const float e0 = edge[((size_t)(pm - 1) * 2 + 0) * FF + f], e1 = edge[((size_t)(pm - 1) * 2 + 1) * FF + f];
        if (rr == 0) gpre += cw[f] * e0 + cw[FF + f] * e1; else gpre += cw[f] * e1;
        H[(size_t)(pm * 256 + rr) * FF + f] = (bf16_t)f2bf(gelu_tanh(gpre) * fixv[((size_t)pm * 2 + rr) * FF + f]);
    }
}


DI void fix_panel(const Args& a, int pm) {
    if ((pm & 31) == 0) return;
    const float* edge = (const float*)(a.ws + WS_EDGE) + (size_t)(pm - 1) * 2 * FF; const float* fixg = (const float*)(a.ws + WS_FIXG) + (size_t)pm * 2 * FF; const float* fixv = (const float*)(a.ws + WS_FIXV) + (size_t)pm * 2 * FF;
    const float* cw = a.in[I_CONVW]; bf16_t* H = (bf16_t*)(a.ws + WS_H) + (size_t)pm * 256 * FF;
    for (int f = threadIdx.x; f < FF; f += 512) {
        const float e0 = edge[f], e1 = edge[FF + f], c0 = cw[f], c1 = cw[FF + f];
        const float g0 = fixg[f] + c0 * e0 + c1 * e1, g1 = fixg[FF + f] + c0 * e1;
        H[f] = (bf16_t)f2bf(gelu_tanh(g0) * fixv[f]); H[FF + f] = (bf16_t)f2bf(gelu_tanh(g1) * fixv[FF + f]);
    }
}

#define XB_TMO      128
#define XB_XCNT(j)  (256  + 64 * (j))
#define XB_XSUB(j)  (1280 + 64 * (j))
#define XB_XGEN(j)  (2304 + 64 * (j))
#define XB_TOP      3328
#define XB_TOPGEN   3392
#define XCD_BAR_WORDS 3456
#define XB_SPIN_CAP (1u << 22)
DI unsigned xb_ld(unsigned* p)              { return __hip_atomic_load(p, __ATOMIC_RELAXED, __HIP_MEMORY_SCOPE_AGENT); }
DI unsigned xb_add(unsigned* p, unsigned v) { return __hip_atomic_fetch_add(p, v, __ATOMIC_RELAXED, __HIP_MEMORY_SCOPE_AGENT); }
DI unsigned xb_xcc_id() { return (unsigned)__builtin_amdgcn_s_getreg((3 << 11) | 20) & 0xFu; }
#define XB_SPIN(cond, bar) do { unsigned _sp = 0; while (cond) { __builtin_amdgcn_s_sleep(1); \
    if ((++_sp & 255u) == 0u) { if (xb_ld(&(bar)[XB_TMO])) break; if (_sp > XB_SPIN_CAP) { atomicAdd(&(bar)[XB_TMO], 1u); break; } } } } while (0)
struct XcdBarrier { unsigned* bar; unsigned x; volatile LAS unsigned* st; };
DI XcdBarrier xcd_barrier_post(unsigned* bar, volatile LAS unsigned* st) {
    XcdBarrier b; b.bar = bar; b.x = xb_xcc_id(); b.st = st;
    if (threadIdx.x == 0) (void)xb_add(&bar[XB_XCNT(b.x)], 1u);
    return b;
}
DI void xcd_barrier_complete(unsigned* bar, unsigned x, unsigned& nloc, unsigned& nx) {
    const unsigned G = gridDim.x * gridDim.y * gridDim.z;
    unsigned sum, cnt, mine, sp = 0u;
    for (;;) {
        sum = 0u; cnt = 0u; mine = 0u;
#pragma unroll
        for (unsigned j = 0; j < 16; ++j) { const unsigned c = xb_ld(&bar[XB_XCNT(j)]); sum += c; cnt += (c > 0u) ? 1u : 0u; mine = (j == x) ? c : mine; }
        if (sum == G) break;
        __builtin_amdgcn_s_sleep(1);
        if ((++sp & 255u) == 0u) { if (xb_ld(&bar[XB_TMO])) break; if (sp > XB_SPIN_CAP) { atomicAdd(&bar[XB_TMO], 1u); break; } }
    }
    nloc = mine > 0u ? mine : 1u; nx = cnt > 0u ? cnt : 1u;
}
DI void xcd_barrier(const XcdBarrier& b) {
    asm volatile("s_waitcnt vmcnt(0)" ::: "memory");
    __syncthreads();
    if (threadIdx.x == 0) {
        unsigned* bar = b.bar;
        __builtin_amdgcn_s_waitcnt(0);
        unsigned nloc = b.st[0], nx = b.st[1];
        if (nloc == 0u) { xcd_barrier_complete(bar, b.x, nloc, nx); b.st[0] = nloc; b.st[1] = nx; }
        const unsigned old = xb_add(&bar[XB_XSUB(b.x)], 1u);
        const unsigned gen = old / nloc;
        if (old + 1u == (gen + 1u) * nloc) {
            __builtin_amdgcn_fence(__ATOMIC_RELEASE, "agent");
            asm volatile("s_waitcnt vmcnt(0)" ::: "memory");
            const unsigned og = xb_add(&bar[XB_TOP], 1u);
            const unsigned tg = og / nx;
            if (og + 1u == (tg + 1u) * nx) xb_add(&bar[XB_TOPGEN], 1u);
            else XB_SPIN(xb_ld(&bar[XB_TOPGEN]) == tg, bar);
            __builtin_amdgcn_fence(__ATOMIC_ACQUIRE, "agent");
            xb_add(&bar[XB_XGEN(b.x)], 1u);
            asm volatile("s_waitcnt vmcnt(0)" ::: "memory");
        } else {
            XB_SPIN(xb_ld(&bar[XB_XGEN(b.x)]) == gen, bar);
            __builtin_amdgcn_fence(__ATOMIC_ACQUIRE, "agent");
            asm volatile("s_waitcnt vmcnt(0)" ::: "memory");
        }
    }
    __syncthreads();
}

constexpr int LDS_BYTES = 147456;
constexpr int XCH_OFF = 131072;

__global__ void __launch_bounds__(512, 2) mega_fwd(Args a) {
    extern __shared__ __attribute__((aligned(16))) unsigned char lds_raw[];
    LAS unsigned char* lds = (LAS unsigned char*)lds_raw;
    cg::grid_group grid = cg::this_grid();
    if (threadIdx.x < 16) ((LAS unsigned*)(lds + LDS_BYTES - 64))[threadIdx.x] = 0u;
    __syncthreads();
    unsigned char* ws = a.ws;
    const int G = gridDim.x, bx = blockIdx.x;
    const float* mod = (const float*)(ws + WS_MOD);

#ifndef PH_MASK
#define PH_MASK 0xFFFF
#endif
#ifndef REP_P2
#define REP_P2 1
#endif
#ifndef REP_P5
#define REP_P5 1
#endif
#ifndef REP_P6
#define REP_P6 1
#endif
#define PH(k) if (PH_MASK & (1 << (k)))
    PH(0) phase0(a, lds);
#ifdef PROBE_DUP0
    __syncthreads(); phase0(a, lds);
#endif
    grid.sync();
    const XcdBarrier xbar = xcd_barrier_post((unsigned*)(ws + WS_BAR), (volatile LAS unsigned*)(lds + LDS_BYTES - 64));
#ifdef PROBE_SYNC10
    for (int i = 0; i < 10; ++i) xcd_barrier(xbar);
#endif
#ifdef PROBE_DUP6
    PROBE_DUP6_BODY
#endif
    PH(1) phase1(a);
    xcd_barrier(xbar);
    for (int rep = 0; rep < REP_P2; ++rep) {
        pg8::Gemm g{(const bf16_t*)(ws + WS_U), (const bf16_t*)(ws + WS_WIN), MROWS, NINP, DM, DM};
        pg8::StaticOrder S; S.init(MROWS, NINP, G, bx);
        EpiIn E{ws, (const float*)(ws + WS_ROPE)};
        pg8::gemm_phase<EpiIn, pg8::StaticOrder>(lds, g, S, E);
    }
    xcd_barrier(xbar);
    PH(3) phase3(a, lds);
    xcd_barrier(xbar);
#ifdef PROBE_DUP3
    phase3(a, lds, 3);
    xcd_barrier(xbar);
#endif
    PH(4) phase4(a, lds);
    xcd_barrier(xbar);
#ifdef PROBE_DUP4
    phase4(a, lds, 2);
    xcd_barrier(xbar);
#endif
    for (int rep = 0; rep < REP_P5; ++rep) {
        pg8::Gemm g{(const bf16_t*)(ws + WS_CAT), (const bf16_t*)(ws + WS_WO), MROWS, DM, DM, DM};
        pg8::StaticOrder S; S.init(MROWS, DM, G, bx);
        EpiPlain E{(bf16_t*)(ws + WS_OP), DM};
        pg8::gemm_phase<EpiPlain, pg8::StaticOrder>(lds, g, S, E);
    }
    xcd_barrier(xbar);
    PH(6) phase5b(a);
    xcd_barrier(xbar);
    for (int rep = 0; rep < REP_P6; ++rep) {
        pg8::Gemm g{(const bf16_t*)(ws + WS_U), (const bf16_t*)(ws + WS_WUP), MROWS, NUP, DM, DM};
        pg8::StaticOrder S; S.init(MROWS, NUP, G, bx);
        EpiUp E{(bf16_t*)(ws + WS_H), a.in[I_CONVW], a.in[I_CONVB], (float*)(ws + WS_EDGE), (float*)(ws + WS_FIXG), (float*)(ws + WS_FIXV), (LAS float*)(lds + XCH_OFF)};
        pg8::gemm_phase<EpiUp, pg8::StaticOrder>(lds, g, S, E);
    }
    xcd_barrier(xbar);
    PH(9) {
        pg8::Gemm g{(const bf16_t*)(ws + WS_H), (const bf16_t*)(ws + WS_WDN), MROWS, DM, FF, FF};
        pg8::StaticOrder S; S.init(MROWS, DM, G, bx);
        { pg8::Unit fu; int lastpm = -1;
          for (int i = 0; S.next(i, fu); ++i) if (fu.pm != lastpm) { fix_panel(a, fu.pm); lastpm = fu.pm; }
          asm volatile("s_waitcnt vmcnt(0)" ::: "memory"); __syncthreads(); }
        EpiPlain E{(bf16_t*)(ws + WS_U), DM};
        pg8::gemm_phase<EpiPlain, pg8::StaticOrder>(lds, g, S, E);
    }
    xcd_barrier(xbar);
    PH(10) phase7b(a);
}

extern "C" void kernel_launch(void* const* d_in, const int* in_sizes, int n_in, void* d_out, int out_size, void* d_ws, size_t ws_size, hipStream_t stream) {
    static int grid = 0;
    if (grid == 0) {
        if (n_in != 19 || out_size != MROWS * DM || ws_size < WS_END) { fprintf(stderr, "kernel_launch: unexpected shapes (n_in %d out %d ws %zu)\n", n_in, out_size, ws_size); grid = -1; return; }
        int dev = 0, cus = 0, per_cu = 0;
        (void)hipGetDevice(&dev);
        (void)hipDeviceGetAttribute(&cus, hipDeviceAttributeMultiprocessorCount, dev);
        if (hipFuncSetAttribute((const void*)mega_fwd, hipFuncAttributeMaxDynamicSharedMemorySize, LDS_BYTES) != hipSuccess) { fprintf(stderr, "kernel_launch: hipFuncSetAttribute failed\n"); grid = -1; return; }
        if (hipOccupancyMaxActiveBlocksPerMultiprocessor(&per_cu, (const void*)mega_fwd, 512, LDS_BYTES) != hipSuccess || per_cu < 1) { fprintf(stderr, "kernel_launch: occupancy query failed (%d)\n", per_cu); per_cu = 1; }
        (void)hipGetLastError();
        grid = cus * per_cu;
    }
    if (grid < 0) return;
    Args a{};
    for (int i = 0; i < 19; ++i) a.in[i] = (const float*)d_in[i];
    a.out = (float*)d_out; a.ws = (unsigned char*)d_ws;
    void* args[] = {&a};
    hipError_t e = hipLaunchCooperativeKernel((const void*)mega_fwd, dim3(grid), dim3(512), args, LDS_BYTES, stream);
    if (e != hipSuccess) fprintf(stderr, "cooperative launch failed: %s (grid %d)\n", hipGetErrorString(e), grid);
}
```

```cpp
#include <hip/hip_runtime.h>
#include <hip/hip_cooperative_groups.h>
#include <cstdio>
#include <cstdint>
namespace cg = cooperative_groups;

#define LAS __attribute__((address_space(3)))
#define DI __device__ __forceinline__
typedef unsigned short bf16_t;
typedef short bf16x8 __attribute__((ext_vector_type(8)));
typedef float f32x4 __attribute__((ext_vector_type(4)));
typedef float f32x2 __attribute__((ext_vector_type(2)));
typedef float f32x16 __attribute__((ext_vector_type(16)));
typedef unsigned u32x4 __attribute__((ext_vector_type(4)));
typedef unsigned u32x2 __attribute__((ext_vector_type(2)));
typedef __bf16 bf16x2_t __attribute__((ext_vector_type(2)));

constexpr int BATCH = 4, SEQ = 8192, DM = 1024, MROWS = BATCH * SEQ, HD = 64;
constexpr int NIN = 2840, NINP = 3072, FF = 2816, NUP = 2 * FF;
constexpr int NHA = 8, NHB = 8, NG = 2;
constexpr int NCP = 512;
constexpr float ALPHA = 1.189207115002721f, LN_EPS = 1e-5f;
constexpr float C2 = 0.125f * 1.4426950408889634f;
constexpr float LN2F = 0.6931471805599453f;
constexpr float NEGBIG = -1e30f;

constexpr size_t MiB = 1u << 20;
constexpr size_t WS_MOD = 0;
constexpr size_t WS_CTR = 512 * 1024;
constexpr size_t WS_BAR = 512 * 1024 + 65536;
constexpr size_t WS_ROPE = 1 * MiB;
constexpr size_t WS_CB = 1 * MiB + 512 * 1024;
constexpr size_t WS_W2C = 1 * MiB + 768 * 1024;
constexpr size_t WS_WIN = 2 * MiB;
constexpr size_t WS_WO = 8 * MiB;
constexpr size_t WS_WUP = 10 * MiB;
constexpr size_t WS_WDN = 21 * MiB;
constexpr size_t WS_WC1 = 27 * MiB;
constexpr size_t WS_GATES = 29 * MiB;
constexpr size_t WS_U = 32 * MiB;
constexpr size_t WS_QA = 96 * MiB, WS_KA = 128 * MiB, WS_VAT = 160 * MiB;
constexpr size_t WS_QB = 256 * MiB, WS_KC = 288 * MiB, WS_VC = 296 * MiB, WS_KS = 304 * MiB, WS_VST = 312 * MiB, WS_KW = 320 * MiB, WS_VWT = 328 * MiB;
constexpr size_t WS_HID = 336 * MiB;
constexpr size_t WS_KCC = 340 * MiB;
constexpr size_t WS_VCCT = 340 * MiB + 512 * 1024;
constexpr size_t WS_LSE = 341 * MiB;
constexpr size_t WS_OP = 344 * MiB;
constexpr size_t WS_CAT = 440 * MiB;
constexpr size_t WS_H = 96 * MiB;
constexpr size_t WS_EDGE = 280 * MiB;
constexpr size_t WS_FIXG = 284 * MiB;
constexpr size_t WS_FIXV = 288 * MiB;
constexpr size_t WS_END = 504 * MiB;

DI unsigned f2bf(float f) { unsigned u = __builtin_bit_cast(unsigned, f); return (u + 0x7fffu + ((u >> 16) & 1u)) >> 16; }
DI unsigned pk2(float lo, float hi) { f32x2 v = {lo, hi}; bf16x2_t b = __builtin_convertvector(v, bf16x2_t); return __builtin_bit_cast(unsigned, b); }
DI float bf2f(unsigned short h) { return __builtin_bit_cast(float, (unsigned)h << 16); }
DI float gelu_tanh(float x) { const float u = 0.7978845608028654f * (x + 0.044715f * x * x * x); return x * __builtin_amdgcn_rcpf(1.0f + __builtin_amdgcn_exp2f(-2.0f * 1.4426950408889634f * u)); }
DI float sigmoidf_(float x) { return 1.0f / (1.0f + __expf(-x)); }
DI float wave_sum(float v) {
#pragma unroll
    for (int o = 1; o < 64; o <<= 1) v += __shfl_xor(v, o);
    return v;
}
template <int CTRL> DI float dppf(float x) { return __builtin_bit_cast(float, __builtin_amdgcn_update_dpp(0, __builtin_bit_cast(int, x), CTRL, 0xf, 0xf, true)); }

namespace pg8 {
constexpr int BM = 256, BK = 64, HALF = 128, HTB = HALF * BK * 2, STAGE_BYTES = 8 * HTB, NXCD = 8, WGM = 8;
DI int lds_byte(int r, int c) { const int st = (r >> 4) * 2 + (c >> 5), rr = r & 15, cc = c & 31, ob = rr * 64 + cc * 2; return st * 1024 + (ob ^ (((ob >> 9) & 1) << 5)); }
DI void stage_rc(int b, int& R, int& C) { const int st = b / 1024, sb = b % 1024, swz = sb ^ (((sb >> 9) & 1) << 5); R = (st >> 1) * 16 + swz / 64; C = (st & 1) * 32 + (swz % 64) / 2; }
DI int perm32(int rho) { const int n = rho >> 4, i = rho & 15; return 8 * (i >> 2) + 4 * n + (i & 3); }
struct Unit { int pm, pn; };
struct Gemm { const bf16_t* A; const bf16_t* Bt; int M, N, K, lda; };
struct StaticOrder {
    int nM, nN, nwg, G, c;
    DI void init(int M, int N, int G_, int c_) { nM = M / BM; nN = N / BM; nwg = nM * nN; G = G_; c = c_; }
    DI bool next(int i, Unit& u) const {
        const long L = (long)i * G + c; if (L >= nwg) return false;
        int wgid = (int)L; { const int q = nwg / NXCD, r = nwg % NXCD, xcd = wgid % NXCD, off = wgid / NXCD; wgid = (xcd < r ? xcd * (q + 1) : r * (q + 1) + (xcd - r) * q) + off; }
        const int nig = WGM * nN, gid = wgid / nig, fm = gid * WGM, gsz = (nM - fm) < WGM ? (nM - fm) : WGM;
        u.pm = fm + ((wgid % nig) % gsz); u.pn = (wgid % nig) / gsz; return true;
    }
};
struct OneUnit { int pm; DI bool next(int i, Unit& u) const { if (i > 0) return false; u.pm = pm; u.pn = 0; return true; } };

template <class Epi, class Sched>
DI void gemm_phase(LAS unsigned char* lds, const Gemm g, const Sched& S, const Epi& E) {
    int tid = threadIdx.x; asm volatile("" : "+v"(tid));
    const int wid = __builtin_amdgcn_readfirstlane(tid >> 6), lane = tid & 63, wr = wid >> 2, wc = wid & 3, fr = lane & 15, fq = lane >> 4;
    const int K = g.K, nt = K / BK, lda = g.lda;
    unsigned voffA[2], voffB[2];
#pragma unroll
    for (int i = 0; i < 2; ++i) { int R, C; stage_rc(tid * 16 + i * 8192, R, C); const int Rb = Epi::PERM ? ((R & ~31) + perm32(R & 31)) : R;
        voffA[i] = (unsigned)(R * lda + C) * 2u; voffB[i] = (unsigned)(Rb * K + C) * 2u; }
    const size_t kstep = (size_t)(BK * 2);
    const size_t hstepA = (size_t)HALF * lda * 2, hstepB = (size_t)HALF * K * 2;
    const size_t tstepA = 2 * hstepA, tstepB = 2 * hstepB;
    const unsigned ldsw = (unsigned)wid * 1024u;
    const int aoff = lds_byte(wr * 64 + fr, fq * 8), boff = lds_byte(wc * 32 + fr, fq * 8);
#define PG8_SA(b, h) (((b) * 2 + (h)) * HTB)
#define PG8_SB(b, h) ((4 + (b) * 2 + (h)) * HTB)
#define PG8_STAGE(bufoff, gbase, voff) do { _Pragma("unroll") for (int _i = 0; _i < 2; ++_i) \
        __builtin_amdgcn_global_load_lds((const unsigned*)((const char*)(gbase) + (voff)[_i]), (LAS unsigned*)(lds + (bufoff) + ldsw + _i * 8192), 16, 0, 0); } while (0)
#define PG8_LDA(dst, b, h) do { _Pragma("unroll") for (int m = 0; m < 4; ++m) _Pragma("unroll") for (int k = 0; k < 2; ++k) dst[m][k] = *(const LAS bf16x8*)(lds + PG8_SA(b, h) + aoff + m * 2048 + k * 1024); } while (0)
#define PG8_LDB(dst, b, h) do { _Pragma("unroll") for (int n = 0; n < 2; ++n) _Pragma("unroll") for (int k = 0; k < 2; ++k) dst[n][k] = *(const LAS bf16x8*)(lds + PG8_SB(b, h) + boff + n * 2048 + k * 1024); } while (0)
#define PG8_MMA(ai, bj, At, Bt) do { __builtin_amdgcn_s_setprio(1); _Pragma("unroll") for (int m = 0; m < 4; ++m) _Pragma("unroll") for (int n = 0; n < 2; ++n) _Pragma("unroll") for (int k = 0; k < 2; ++k) \
        acc[ai][bj][m][n] = __builtin_amdgcn_mfma_f32_16x16x32_bf16(Bt[n][k], At[m][k], acc[ai][bj][m][n], 0, 0, 0); __builtin_amdgcn_s_setprio(0); } while (0)
#define PG8_WAIT_V(n) asm volatile("s_waitcnt vmcnt(" #n ")" ::: "memory")
#define PG8_WAIT_L(n) asm volatile("s_waitcnt lgkmcnt(" #n ")" ::: "memory")
#define PG8_BAR __builtin_amdgcn_s_barrier()
#define PG8_SCHED __builtin_amdgcn_sched_barrier(0)
    Unit cur, nxt; int ui = 0;
    if (!S.next(0, cur)) return;
    f32x4 acc[2][2][4][2];
#pragma unroll
    for (int a = 0; a < 2; ++a)
#pragma unroll
        for (int b = 0; b < 2; ++b)
#pragma unroll
            for (int m = 0; m < 4; ++m)
#pragma unroll
                for (int n = 0; n < 2; ++n) acc[a][b][m][n] = (f32x4){0.f, 0.f, 0.f, 0.f};
    bf16x8 At[4][2], B0[2][2], B1[2][2];
    const char* cA = (const char*)g.A + (size_t)cur.pm * tstepA; const char* cB = (const char*)g.Bt + (size_t)cur.pn * tstepB;
    PG8_STAGE(PG8_SB(0, 0), cB, voffB); PG8_STAGE(PG8_SB(0, 1), cB + hstepB, voffB); PG8_STAGE(PG8_SA(0, 0), cA, voffA); PG8_STAGE(PG8_SA(0, 1), cA + hstepA, voffA);
    if (wr == 1) PG8_BAR;
    PG8_WAIT_V(2); PG8_BAR;
    PG8_STAGE(PG8_SB(1, 0), cB + kstep, voffB); PG8_STAGE(PG8_SA(1, 0), cA + kstep, voffA); PG8_STAGE(PG8_SB(1, 1), cB + hstepB + kstep, voffB);
    PG8_WAIT_V(6); PG8_BAR;
    for (;;) {
        const bool has_next = S.next(ui + 1, nxt);
        const char* nA = has_next ? (const char*)g.A + (size_t)nxt.pm * tstepA : cA; const char* nB = has_next ? (const char*)g.Bt + (size_t)nxt.pn * tstepB : cB;
        for (int t = 0; t < nt; t += 2) {
            const bool last = (t == nt - 2);
            const char* a1 = cA + (size_t)(t + 1) * kstep;
            const char* a2 = last ? nA : cA + (size_t)(t + 2) * kstep; const char* b2 = last ? nB : cB + (size_t)(t + 2) * kstep;
            const char* a3 = a2 + kstep; const char* b3 = b2 + kstep;
            PG8_LDB(B0, 0, 0); PG8_LDB(B1, 0, 1); PG8_SCHED; PG8_LDA(At, 0, 0); PG8_STAGE(PG8_SA(1, 1), a1 + hstepA, voffA);
            PG8_WAIT_V(8); PG8_WAIT_L(0); PG8_BAR; PG8_MMA(0, 0, At, B0); PG8_MMA(0, 1, At, B1); PG8_BAR; PG8_SCHED;
            PG8_LDA(At, 0, 1); PG8_STAGE(PG8_SB(0, 0), b2, voffB); PG8_STAGE(PG8_SB(0, 1), b2 + hstepB, voffB); PG8_STAGE(PG8_SA(0, 0), a2, voffA);
            PG8_WAIT_V(8); PG8_WAIT_L(0); PG8_BAR; PG8_MMA(1, 0, At, B0); PG8_MMA(1, 1, At, B1); PG8_BAR; PG8_SCHED;
            PG8_LDB(B0, 1, 0); PG8_LDB(B1, 1, 1); PG8_SCHED; PG8_LDA(At, 1, 0); PG8_STAGE(PG8_SA(0, 1), a2 + hstepA, voffA);
            PG8_WAIT_V(8); PG8_WAIT_L(0); PG8_BAR; PG8_MMA(0, 0, At, B0); PG8_MMA(0, 1, At, B1); PG8_BAR; PG8_SCHED;
            PG8_LDA(At, 1, 1); PG8_STAGE(PG8_SB(1, 0), b3, voffB); PG8_STAGE(PG8_SB(1, 1), b3 + hstepB, voffB); PG8_STAGE(PG8_SA(1, 0), a3, voffA);
            PG8_WAIT_V(8); PG8_WAIT_L(0); PG8_BAR; PG8_MMA(1, 0, At, B0); PG8_MMA(1, 1, At, B1); PG8_BAR; PG8_SCHED;
        }
        if (wr == 0) PG8_BAR;
        E(acc, cur, wr, wc, fr, fq);
        if (!has_next) break;
#pragma unroll
        for (int a = 0; a < 2; ++a)
#pragma unroll
            for (int b = 0; b < 2; ++b)
#pragma unroll
                for (int m = 0; m < 4; ++m)
#pragma unroll
                    for (int n = 0; n < 2; ++n) acc[a][b][m][n] = (f32x4){0.f, 0.f, 0.f, 0.f};
        cur = nxt; cA = nA; cB = nB; ++ui;
        if (wr == 1) PG8_BAR;
    }
    PG8_WAIT_V(0);
    PG8_BAR;
#undef PG8_SA
#undef PG8_SB
#undef PG8_STAGE
#undef PG8_LDA
#undef PG8_LDB
#undef PG8_MMA
#undef PG8_WAIT_V
#undef PG8_WAIT_L
#undef PG8_BAR
#undef PG8_SCHED
}
}
using pg8::Unit;
typedef f32x4 AccT[2][2][4][2];

struct EpiIn {
    static constexpr bool PERM = true;
    unsigned char* ws; const float* rope;
    DI void operator()(const AccT& acc, const Unit& u, int wr, int wc, int fr, int fq) const {
        const int lane = threadIdx.x & 63;
#pragma unroll
        for (int bj = 0; bj < 2; ++bj) {
            const int seg = u.pn * 2 + bj;
            if (seg >= 23) continue;
            const int hs = wc >> 1;
            const int d0 = 32 * (wc & 1) + 8 * fq;
            int kind;
            bf16_t* base = nullptr; int nh = 8, head = 0; float sc = 1.f;
            if (seg < 4)       { kind = 0; base = (bf16_t*)(ws + WS_QA); head = seg * 2 + hs; sc = C2; }
            else if (seg < 8)  { kind = 0; base = (bf16_t*)(ws + WS_KA); head = (seg - 4) * 2 + hs; }
            else if (seg < 12) { kind = 3; base = (bf16_t*)(ws + WS_VAT); head = (seg - 8) * 2 + hs; }
            else if (seg < 16) { kind = 0; base = (bf16_t*)(ws + WS_QB); head = (seg - 12) * 2 + hs; sc = C2; }
            else if (seg == 16) { kind = 0; base = (bf16_t*)(ws + WS_KC); nh = 2; head = hs; }
            else if (seg == 17) { kind = 3; base = (bf16_t*)(ws + WS_VC); nh = 2; head = hs; }
            else if (seg == 18) { kind = 0; base = (bf16_t*)(ws + WS_KS); nh = 2; head = hs; }
            else if (seg == 19) { kind = 3; base = (bf16_t*)(ws + WS_VST); nh = 2; head = hs; }
            else if (seg == 20) { kind = 0; base = (bf16_t*)(ws + WS_KW); nh = 2; head = hs; }
            else if (seg == 21) { kind = 3; base = (bf16_t*)(ws + WS_VWT); nh = 2; head = hs; }
            else { kind = 4; }
            const bool do_rope = (kind == 0) && ((wc & 1) == 0);
#pragma unroll
            for (int ai = 0; ai < 2; ++ai)
#pragma unroll
                for (int m = 0; m < 4; ++m) {
                    const int row = u.pm * 256 + ai * 128 + wr * 64 + m * 16 + fr;
                    const int b = row >> 13, s = row & (SEQ - 1);
                    float v[8];
#pragma unroll
                    for (int n = 0; n < 2; ++n)
#pragma unroll
                        for (int j = 0; j < 4; ++j) v[n * 4 + j] = acc[ai][bj][m][n][j];
                    if (do_rope) {
                        const f32x4* rp = (const f32x4*)(rope + (size_t)s * 16);
#pragma unroll
                        for (int e2 = 0; e2 < 4; ++e2) {
                            f32x4 cs = (fq < 2) ? rp[e2] : (f32x4){1.f, 0.f, 1.f, 0.f};
#pragma unroll
                            for (int q = 0; q < 2; ++q) {
                                const int e = e2 * 2 + q; const float c = cs[2 * q], sn = cs[2 * q + 1];
                                const float other = __shfl_xor(v[e], 16);
                                const float r0 = v[e] * c - other * sn;
                                const float r1 = other * sn + v[e] * c;
                                v[e] = (fq == 0) ? r0 : ((fq == 1) ? r1 : v[e]);
                            }
                        }
                    }
                    if (kind == 0 || kind == 3) {
                        u32x4 w; w.x = pk2(v[0] * sc, v[1] * sc); w.y = pk2(v[2] * sc, v[3] * sc); w.z = pk2(v[4] * sc, v[5] * sc); w.w = pk2(v[6] * sc, v[7] * sc);
                        *(u32x4*)(base + ((size_t)(b * nh + head) * SEQ + s) * HD + d0) = w;
                    } else if (kind == 2 || kind == 1) {
                        const size_t hb = (size_t)(b * nh + head) * HD * SEQ + d0 * 32;
                        bf16_t* p1 = base + hb + (size_t)(s >> 5) * 2048 + (s & 31);
                        const int g4 = (s & 3) * (SEQ / 4) + (s >> 2);
                        bf16_t* p4 = base + (size_t)MROWS * 512 + hb + (size_t)(g4 >> 5) * 2048 + (g4 & 31);
#pragma unroll
                        for (int e = 0; e < 8; ++e) {
                            const float a1 = dppf<0x101>(v[e]), a2 = dppf<0x102>(v[e]), a3 = dppf<0x103>(v[e]);
                            if ((fr & 3) == 0) { u32x2 w; w.x = pk2(v[e], a1); w.y = pk2(a2, a3); *(u32x2*)(p1 + e * 32) = w; }
                            if (kind == 1) {
                                const float c1 = dppf<0x104>(v[e]), c2 = dppf<0x108>(v[e]), c3 = dppf<0x10C>(v[e]);
                                if (fr < 4) { u32x2 w; w.x = pk2(v[e], c1); w.y = pk2(c2, c3); *(u32x2*)(p4 + e * 32) = w; }
                            }
                        }
                    } else {
                        const int c0 = 32 * wc + 8 * fq;
                        if (c0 < 24) { float* gp = (float*)(ws + WS_GATES) + (size_t)row * 24 + c0;
#pragma unroll
                            for (int e = 0; e < 8; ++e) gp[e] = sigmoidf_(v[e]); }
                    }
                }
            if (kind == 1) {
#pragma unroll
                for (int ai = 0; ai < 2; ++ai) {
                    const int row0 = u.pm * 256 + ai * 128 + wr * 64 + fr;
                    const int b = row0 >> 13, s0 = row0 & (SEQ - 1);
                    const int g16 = (s0 & 15) * (SEQ / 16) + (s0 >> 4);
                    bf16_t* p16 = base + (size_t)2 * MROWS * 512 + (size_t)(b * nh + head) * HD * SEQ + d0 * 32 + (size_t)(g16 >> 5) * 2048 + (g16 & 31);
#pragma unroll
                    for (int n = 0; n < 2; ++n)
#pragma unroll
                        for (int j = 0; j < 4; ++j) { u32x2 w; w.x = pk2(acc[ai][bj][0][n][j], acc[ai][bj][1][n][j]); w.y = pk2(acc[ai][bj][2][n][j], acc[ai][bj][3][n][j]); *(u32x2*)(p16 + (n * 4 + j) * 32) = w; }
                }
            }
        }
        (void)lane;
    }
};
struct EpiHid {
    static constexpr bool PERM = true;
    bf16_t* O; const float* bias;
    DI void operator()(const AccT& acc, const Unit& u, int wr, int wc, int fr, int fq) const {
#pragma unroll
        for (int bj = 0; bj < 2; ++bj) {
            const int col0 = bj * 128 + wc * 32 + 8 * fq;
            float bv[8];
#pragma unroll
            for (int e = 0; e < 8; ++e) bv[e] = bias[col0 + e];
#pragma unroll
            for (int ai = 0; ai < 2; ++ai)
#pragma unroll
                for (int m = 0; m < 4; ++m) {
                    const int row = u.pm * 256 + ai * 128 + wr * 64 + m * 16 + fr;
                    float v[8];
#pragma unroll
                    for (int n = 0; n < 2; ++n)
#pragma unroll
                        for (int j = 0; j < 4; ++j) v[n * 4 + j] = gelu_tanh(acc[ai][bj][m][n][j] + bv[n * 4 + j]);
                    u32x4 w; w.x = pk2(v[0], v[1]); w.y = pk2(v[2], v[3]); w.z = pk2(v[4], v[5]); w.w = pk2(v[6], v[7]);
                    *(u32x4*)(O + (size_t)row * 256 + col0) = w;
                }
        }
    }
};
struct EpiPlain {
    static constexpr bool PERM = true;
    bf16_t* O; int ldc;
    DI void operator()(const AccT& acc, const Unit& u, int wr, int wc, int fr, int fq) const {
#pragma unroll
        for (int bj = 0; bj < 2; ++bj) {
            const int col0 = u.pn * 256 + bj * 128 + wc * 32 + 8 * fq;
#pragma unroll
            for (int ai = 0; ai < 2; ++ai)
#pragma unroll
                for (int m = 0; m < 4; ++m) {
                    const int row = u.pm * 256 + ai * 128 + wr * 64 + m * 16 + fr;
                    u32x4 w; w.x = pk2(acc[ai][bj][m][0][0], acc[ai][bj][m][0][1]); w.y = pk2(acc[ai][bj][m][0][2], acc[ai][bj][m][0][3]);
                    w.z = pk2(acc[ai][bj][m][1][0], acc[ai][bj][m][1][1]); w.w = pk2(acc[ai][bj][m][1][2], acc[ai][bj][m][1][3]);
                    *(u32x4*)(O + (size_t)row * ldc + col0) = w;
                }
        }
    }
};
struct EpiRes {
    static constexpr bool PERM = false;
    const float* base; float* out; const float* gate;
    DI void operator()(const AccT& acc, const Unit& u, int wr, int wc, int fr, int fq) const {
#pragma unroll
        for (int bj = 0; bj < 2; ++bj)
#pragma unroll
            for (int n = 0; n < 2; ++n) {
                const int col = u.pn * 256 + bj * 128 + wc * 32 + n * 16 + 4 * fq;
                const int b = (u.pm * 256) >> 13;
                const f32x4 gv = *(const f32x4*)(gate + (size_t)b * 6144 + col);
#pragma unroll
                for (int ai = 0; ai < 2; ++ai)
#pragma unroll
                    for (int m = 0; m < 4; ++m) {
                        const size_t off = (size_t)(u.pm * 256 + ai * 128 + wr * 64 + m * 16 + fr) * DM + col;
                        const f32x4 bs = *(const f32x4*)(base + off);
                        *(f32x4*)(out + off) = bs * ALPHA + gv * acc[ai][bj][m][n];
                    }
            }
    }
};
struct EpiUp {
    static constexpr bool PERM = true;
    bf16_t* H; const float* cw; const float* cb; float* edge; float* fixg; float* fixv; LAS float* xch;
    DI void operator()(const AccT& acc, const Unit& u, int wr, int wc, int fr, int fq) const {
        const int fcol = 32 * wc + 8 * fq;
        const int f0 = u.pn * 128 + fcol;
        if (fr >= 14) {
#pragma unroll
            for (int ai = 0; ai < 2; ++ai) {
                LAS float* xp = xch + ((ai * 2 + wr) * 2 + (fr - 14)) * 128 + fcol;
                *(LAS f32x4*)(xp) = acc[ai][0][3][0]; *(LAS f32x4*)(xp + 4) = acc[ai][0][3][1];
                if (ai == 1 && wr == 1) { float* ep = edge + ((size_t)u.pm * 2 + (fr - 14)) * FF + f0; *(f32x4*)ep = acc[1][0][3][0]; *(f32x4*)(ep + 4) = acc[1][0][3][1]; }
            }
        }
        asm volatile("s_waitcnt lgkmcnt(0)" ::: "memory"); __builtin_amdgcn_s_barrier(); asm volatile("" ::: "memory");
        float w0[8], w1[8], w2[8], bb[8];
#pragma unroll
        for (int e = 0; e < 8; ++e) { w0[e] = cw[f0 + e]; w1[e] = cw[FF + f0 + e]; w2[e] = cw[2 * FF + f0 + e]; bb[e] = cb[f0 + e]; }
#pragma unroll
        for (int ai = 0; ai < 2; ++ai) {
            float x62[8], x63[8];
            const bool has_src = !(ai == 0 && wr == 0);
            const int src = (wr == 1) ? (ai * 2) : 1;
#pragma unroll
            for (int e = 0; e < 8; ++e) { x62[e] = 0.f; x63[e] = 0.f; }
            if (has_src && fr < 2) {
                const LAS float* xp = xch + (src * 2) * 128 + fcol;
#pragma unroll
                for (int e = 0; e < 8; ++e) { x62[e] = xp[e]; x63[e] = xp[128 + e]; }
            }
#pragma unroll
            for (int m = 0; m < 4; ++m) {
                const int rt = ai * 128 + wr * 64 + m * 16 + fr;
                const int row = u.pm * 256 + rt;
                float hv[8];
#pragma unroll
                for (int n = 0; n < 2; ++n)
#pragma unroll
                    for (int j = 0; j < 4; ++j) {
                        const int e = n * 4 + j;
                        const float a = acc[ai][0][m][n][j];
                        float p1 = dppf<0x111>(a), p2 = dppf<0x112>(a);
                        float q1, q2;
                        if (m > 0) { const float am = acc[ai][0][m > 0 ? m - 1 : 0][n][j]; q1 = dppf<0x10F>(am); q2 = dppf<0x10E>(am); }
                        else { q1 = x63[e]; q2 = (fr == 0) ? x62[e] : x63[e]; }
                        if (fr < 1) p1 = q1;
                        if (fr < 2) p2 = q2;
                        const float gpre = w0[e] * p2 + w1[e] * p1 + w2[e] * a + bb[e];
                        hv[e] = gelu_tanh(gpre) * acc[ai][1][m][n][j];
                        if (ai == 0 && wr == 0 && m == 0 && fr < 2) {
                            fixg[((size_t)u.pm * 2 + fr) * FF + f0 + e] = gpre; fixv[((size_t)u.pm * 2 + fr) * FF + f0 + e] = acc[0][1][0][n][j];
                        }
                    }
                u32x4 w; w.x = pk2(hv[0], hv[1]); w.y = pk2(hv[2], hv[3]); w.z = pk2(hv[4], hv[5]); w.w = pk2(hv[6], hv[7]);
                *(u32x4*)(H + (size_t)row * FF + f0) = w;
            }
        }
    }
};

#define MFMA32(a, b, c) __builtin_amdgcn_mfma_f32_32x32x16_bf16((a), (b), (c), 0, 0, 0)
DI int kvmap(int i) { return (i & 0x13) | ((i & 4) << 1) | ((i & 8) >> 1); }
DI int kvl_of(int r, int hi) { return 16 * (r >> 3) + 8 * hi + (r & 7); }
DI bf16x8 pack8(const f32x16& s, int b) { u32x4 w; w.x = pk2(s[b], s[b + 1]); w.y = pk2(s[b + 2], s[b + 3]); w.z = pk2(s[b + 4], s[b + 5]); w.w = pk2(s[b + 6], s[b + 7]); return __builtin_bit_cast(bf16x8, w); }
DI f32x16 splat16(float v) { f32x16 r;
#pragma unroll
    for (int i = 0; i < 16; ++i) r[i] = v;
    return r; }
template <int CTRL> DI int dppi(int x) { return __builtin_amdgcn_update_dpp(0, x, CTRL, 0xf, 0xf, true); }
DI int sum8(int c) { c += dppi<0xB1>(c); c += dppi<0x4E>(c); c += dppi<0x141>(c); return c; }
struct FA2 { float mref, l; bool inited; f32x16 o0, o1; };
DI void fa2_init(FA2& st) { st.mref = 0.f; st.l = 0.f; st.inited = false;
#pragma unroll
    for (int r = 0; r < 16; ++r) { st.o0[r] = 0.f; st.o1[r] = 0.f; } }
DI void fa2_step(FA2& st, const bf16x8 (&kf)[4], const bf16x8 (&vf)[2][2], const bf16x8 (&qf)[4], bool sel, bool needmask, unsigned vm) {
    f32x16 s = MFMA32(kf[0], qf[0], splat16(0.f));
    s = MFMA32(kf[1], qf[1], s); s = MFMA32(kf[2], qf[2], s); s = MFMA32(kf[3], qf[3], s);
    if (needmask) {
#pragma unroll
        for (int r = 0; r < 16; ++r) s[r] = ((vm >> r) & 1u) ? s[r] : NEGBIG;
    }
    float r0 = fmaxf(fmaxf(s[0], s[1]), s[2]), r1 = fmaxf(fmaxf(s[3], s[4]), s[5]);
    r0 = fmaxf(fmaxf(r0, s[6]), s[7]); r1 = fmaxf(fmaxf(r1, s[8]), s[9]);
    r0 = fmaxf(fmaxf(r0, s[10]), s[11]); r1 = fmaxf(fmaxf(r1, s[12]), s[13]);
    float rm = fmaxf(fmaxf(r0, r1), fmaxf(s[14], s[15]));
    rm = fmaxf(rm, __shfl_xor(rm, 32));
    const bool valid = sel && (rm > -1e29f);
    const float rel = rm - st.mref;
    const bool need = valid && (rel > 8.0f || !st.inited);
    const float delta = need ? rel : 0.f;
    st.mref += delta;
    if (__builtin_expect(__any(need) != 0, 0)) {
        const float f = __builtin_amdgcn_exp2f(st.inited ? -delta : 0.f);
        asm volatile("s_nop 4\n\tv_mul_f32 %0, %0, %1" : "+v"(st.l) : "v"(f));
#pragma unroll
        for (int r = 0; r < 16; ++r) { asm volatile("v_mul_f32 %0, %0, %1" : "+v"(st.o0[r]) : "v"(f)); asm volatile("v_mul_f32 %0, %0, %1" : "+v"(st.o1[r]) : "v"(f)); }
    }
    st.inited = st.inited || valid;
    const float msub = sel ? st.mref : 1e30f;
    float ls0 = 0.f, ls1 = 0.f;
#pragma unroll
    for (int r = 0; r < 16; r += 2) { s[r] = __builtin_amdgcn_exp2f(s[r] - msub); s[r + 1] = __builtin_amdgcn_exp2f(s[r + 1] - msub); ls0 += s[r]; ls1 += s[r + 1]; }
    st.l += ls0 + ls1;
    const bf16x8 p0 = pack8(s, 0), p1 = pack8(s, 8);
    st.o0 = MFMA32(vf[0][0], p0, st.o0); st.o0 = MFMA32(vf[0][1], p1, st.o0);
    st.o1 = MFMA32(vf[1][0], p0, st.o1); st.o1 = MFMA32(vf[1][1], p1, st.o1);
}
typedef short v4i16_t __attribute__((ext_vector_type(4)));
DI void tr_offsets(int lane, int (&toff)[2][2][2]) {
    const int li = lane & 15, q = li >> 2, pp = li & 3, g = lane >> 4, hi = g >> 1;
#pragma unroll
    for (int db = 0; db < 2; ++db)
#pragma unroll
        for (int ks = 0; ks < 2; ++ks)
#pragma unroll
            for (int h4 = 0; h4 < 2; ++h4) {
                const int row = 16 * ks + 8 * hi + 4 * h4 + q, col = 32 * db + 16 * (g & 1) + 4 * pp;
                toff[db][ks][h4] = row * 128 + ((((col >> 3)) ^ ((row >> 1) & 7)) << 4) + (col & 4) * 2;
            }
}
DI void read_v_tr(const LAS unsigned char* tile, const int (&toff)[2][2][2], bf16x8 (&vf)[2][2]) {
#pragma unroll
    for (int db = 0; db < 2; ++db)
#pragma unroll
        for (int ks = 0; ks < 2; ++ks) {
            const v4i16_t lo = __builtin_amdgcn_ds_read_tr16_b64_v4i16((LAS v4i16_t*)(tile + toff[db][ks][0]));
            const v4i16_t hh = __builtin_amdgcn_ds_read_tr16_b64_v4i16((LAS v4i16_t*)(tile + toff[db][ks][1]));
            vf[db][ks] = (bf16x8){lo[0], lo[1], lo[2], lo[3], hh[0], hh[1], hh[2], hh[3]};
        }
}
DI void fa2_pair(FA2& st, const bf16x8 (&kA)[4], const bf16x8 (&vA)[2][2], const bf16x8 (&kB)[4], const bf16x8 (&vB)[2][2], const bf16x8 (&qf)[4],
                 bool sel, bool nmA, unsigned vmA, bool nmB, unsigned vmB) {
    f32x16 sa = MFMA32(kA[0], qf[0], splat16(0.f)), sb = MFMA32(kB[0], qf[0], splat16(0.f));
    sa = MFMA32(kA[1], qf[1], sa); sb = MFMA32(kB[1], qf[1], sb);
    sa = MFMA32(kA[2], qf[2], sa); sb = MFMA32(kB[2], qf[2], sb);
    sa = MFMA32(kA[3], qf[3], sa); sb = MFMA32(kB[3], qf[3], sb);
    if (nmA) {
#pragma unroll
        for (int r = 0; r < 16; ++r) sa[r] = ((vmA >> r) & 1u) ? sa[r] : NEGBIG;
    }
    if (nmB) {
#pragma unroll
        for (int r = 0; r < 16; ++r) sb[r] = ((vmB >> r) & 1u) ? sb[r] : NEGBIG;
    }
    float r0 = fmaxf(fmaxf(sa[0], sa[1]), sa[2]), r1 = fmaxf(fmaxf(sb[0], sb[1]), sb[2]);
#pragma unroll
    for (int r = 3; r < 15; r += 2) { r0 = fmaxf(fmaxf(r0, sa[r]), sa[r + 1]); r1 = fmaxf(fmaxf(r1, sb[r]), sb[r + 1]); }
    float rm = fmaxf(fmaxf(r0, r1), fmaxf(sa[15], sb[15]));
    rm = fmaxf(rm, __shfl_xor(rm, 32));
    const bool valid = sel && (rm > -1e29f);
    const float rel = rm - st.mref;
    const bool need = valid && (rel > 8.0f || !st.inited);
    const float delta = need ? rel : 0.f;
    st.mref += delta;
    if (__builtin_expect(__any(need) != 0, 0)) {
        const float f = __builtin_amdgcn_exp2f(st.inited ? -delta : 0.f);
        asm volatile("s_nop 4\n\tv_mul_f32 %0, %0, %1" : "+v"(st.l) : "v"(f));
#pragma unroll
        for (int r = 0; r < 16; ++r) { asm volatile("v_mul_f32 %0, %0, %1" : "+v"(st.o0[r]) : "v"(f)); asm volatile("v_mul_f32 %0, %0, %1" : "+v"(st.o1[r]) : "v"(f)); }
    }
    st.inited = st.inited || valid;
    const float msub = sel ? st.mref : 1e30f;
    float ls0 = 0.f, ls1 = 0.f;
#pragma unroll
    for (int r = 0; r < 16; ++r) { sa[r] = __builtin_amdgcn_exp2f(sa[r] - msub); sb[r] = __builtin_amdgcn_exp2f(sb[r] - msub); ls0 += sa[r]; ls1 += sb[r]; }
    st.l += ls0 + ls1;
    const bf16x8 pa0 = pack8(sa, 0), pa1 = pack8(sa, 8), pb0 = pack8(sb, 0), pb1 = pack8(sb, 8);
    st.o0 = MFMA32(vA[0][0], pa0, st.o0); st.o1 = MFMA32(vA[1][0], pa0, st.o1);
    st.o0 = MFMA32(vA[0][1], pa1, st.o0); st.o1 = MFMA32(vA[1][1], pa1, st.o1);
    st.o0 = MFMA32(vB[0][0], pb0, st.o0); st.o1 = MFMA32(vB[1][0], pb0, st.o1);
    st.o0 = MFMA32(vB[0][1], pb1, st.o0); st.o1 = MFMA32(vB[1][1], pb1, st.o1);
}
DI void fa2_pair_latev(FA2& st, const bf16x8 (&kA)[4], const LAS unsigned char* vtA, const bf16x8 (&kB)[4], const LAS unsigned char* vtB, const int (&toff)[2][2][2], const bf16x8 (&qf)[4],
                 bool sel, bool nmA, unsigned vmA, bool nmB, unsigned vmB) {
    f32x16 sa = MFMA32(kA[0], qf[0], splat16(0.f)), sb = MFMA32(kB[0], qf[0], splat16(0.f));
    sa = MFMA32(kA[1], qf[1], sa); sb = MFMA32(kB[1], qf[1], sb);
    sa = MFMA32(kA[2], qf[2], sa); sb = MFMA32(kB[2], qf[2], sb);
    sa = MFMA32(kA[3], qf[3], sa); sb = MFMA32(kB[3], qf[3], sb);
    if (nmA) {
#pragma unroll
        for (int r = 0; r < 16; ++r) sa[r] = ((vmA >> r) & 1u) ? sa[r] : NEGBIG;
    }
    if (nmB) {
#pragma unroll
        for (int r = 0; r < 16; ++r) sb[r] = ((vmB >> r) & 1u) ? sb[r] : NEGBIG;
    }
    float r0 = fmaxf(fmaxf(sa[0], sa[1]), sa[2]), r1 = fmaxf(fmaxf(sb[0], sb[1]), sb[2]);
#pragma unroll
    for (int r = 3; r < 15; r += 2) { r0 = fmaxf(fmaxf(r0, sa[r]), sa[r + 1]); r1 = fmaxf(fmaxf(r1, sb[r]), sb[r + 1]); }
    float rm = fmaxf(fmaxf(r0, r1), fmaxf(sa[15], sb[15]));
    rm = fmaxf(rm, __shfl_xor(rm, 32));
    const bool valid = sel && (rm > -1e29f);
    const float rel = rm - st.mref;
    const bool need = valid && (rel > 8.0f || !st.inited);
    const float delta = need ? rel : 0.f;
    st.mref += delta;
    if (__builtin_expect(__any(need) != 0, 0)) {
        const float f = __builtin_amdgcn_exp2f(st.inited ? -delta : 0.f);
        asm volatile("s_nop 4\n\tv_mul_f32 %0, %0, %1" : "+v"(st.l) : "v"(f));
#pragma unroll
        for (int r = 0; r < 16; ++r) { asm volatile("v_mul_f32 %0, %0, %1" : "+v"(st.o0[r]) : "v"(f)); asm volatile("v_mul_f32 %0, %0, %1" : "+v"(st.o1[r]) : "v"(f)); }
    }
    st.inited = st.inited || valid;
    const float msub = sel ? st.mref : 1e30f;
    float ls0 = 0.f, ls1 = 0.f;
#pragma unroll
    for (int r = 0; r < 16; ++r) { sa[r] = __builtin_amdgcn_exp2f(sa[r] - msub); sb[r] = __builtin_amdgcn_exp2f(sb[r] - msub); ls0 += sa[r]; ls1 += sb[r]; }
    st.l += ls0 + ls1;
    const bf16x8 pa0 = pack8(sa, 0), pa1 = pack8(sa, 8), pb0 = pack8(sb, 0), pb1 = pack8(sb, 8);
    asm volatile("" ::: "memory");
    bf16x8 vA[2][2], vB[2][2];
    read_v_tr(vtA, toff, vA); read_v_tr(vtB, toff, vB);
    st.o0 = MFMA32(vA[0][0], pa0, st.o0); st.o1 = MFMA32(vA[1][0], pa0, st.o1);
    st.o0 = MFMA32(vA[0][1], pa1, st.o0); st.o1 = MFMA32(vA[1][1], pa1, st.o1);
    st.o0 = MFMA32(vB[0][0], pb0, st.o0); st.o1 = MFMA32(vB[1][0], pb0, st.o1);
    st.o0 = MFMA32(vB[0][1], pb1, st.o0); st.o1 = MFMA32(vB[1][1], pb1, st.o1);
}
DI void load_k(bf16x8 (&kf)[4], const bf16_t* krow, int hi) {
#pragma unroll
    for (int kk = 0; kk < 4; ++kk) kf[kk] = *(const bf16x8*)(krow + 16 * kk + 8 * hi);
}
DI void load_vt(bf16x8 (&vf)[2][2], const bf16_t* vt, int i32, int hi) {
#pragma unroll
    for (int db = 0; db < 2; ++db)
#pragma unroll
        for (int ks = 0; ks < 2; ++ks) vf[db][ks] = *(const bf16x8*)(vt + (32 * db + i32) * 32 + 16 * ks + 8 * hi);
}
DI void store_o(bf16_t* dst, const f32x16& o0, const f32x16& o1, float scale, int hi) {
#pragma unroll
    for (int g4 = 0; g4 < 4; ++g4) {
        u32x2 a; a.x = pk2(o0[4 * g4] * scale, o0[4 * g4 + 1] * scale); a.y = pk2(o0[4 * g4 + 2] * scale, o0[4 * g4 + 3] * scale);
        u32x2 b; b.x = pk2(o1[4 * g4] * scale, o1[4 * g4 + 1] * scale); b.y = pk2(o1[4 * g4 + 2] * scale, o1[4 * g4 + 3] * scale);
        *(u32x2*)(dst + 8 * g4 + 4 * hi) = a; *(u32x2*)(dst + 32 + 8 * g4 + 4 * hi) = b;
    }
}
template <class KAddr, class VAddr, class NeedF, class MaskF>
DI void fa2_loop(FA2& st, const bf16x8 (&qf)[4], int t_first, int t_last, KAddr kaddr, VAddr vaddr, NeedF needmask, MaskF maskf, int i32, int hi) {
    if (t_first > t_last) return;
    bf16x8 kA[4], vA[2][2], kB[4], vB[2][2], kC[4], vC[2][2];
    load_k(kA, kaddr(t_first), hi); load_vt(vA, vaddr(t_first), i32, hi);
    if (t_first + 1 <= t_last) { load_k(kB, kaddr(t_first + 1), hi); load_vt(vB, vaddr(t_first + 1), i32, hi); }
#define FA2_STAGE(KC_, VC_, KN_, VN_, tt) do { const int t__ = (tt); if (t__ <= t_last) { \
        if (t__ + 2 <= t_last) { load_k(KN_, kaddr(t__ + 2), hi); load_vt(VN_, vaddr(t__ + 2), i32, hi); } \
        const bool nm__ = needmask(t__); unsigned vm__ = 0xffffu; if (nm__) vm__ = maskf(t__); \
        fa2_step(st, KC_, VC_, qf, true, nm__, vm__); } } while (0)
#pragma unroll 1
    for (int t = t_first; t <= t_last; t += 3) {
        FA2_STAGE(kA, vA, kC, vC, t);
        FA2_STAGE(kB, vB, kA, vA, t + 1);
        FA2_STAGE(kC, vC, kB, vB, t + 2);
    }
#undef FA2_STAGE
}

DI void dilated_block_unit(unsigned char* ws, LAS unsigned char* lds, int unit) {
    int tid = threadIdx.x; asm volatile("" : "+v"(tid));
    const int lane = tid & 63, wid = __builtin_amdgcn_readfirstlane(tid >> 6), i32 = lane & 31, hi = lane >> 5;
    const int p = unit >> 10; int rem = unit & 1023; const int bh = rem >> 5; rem &= 31;
    const int d = (p == 0) ? 1 : (p == 1 ? 4 : 16); const int L = SEQ / d, ng8 = L / 256;
    const int r = rem / ng8, ib0 = 8 * (rem % ng8), ib = ib0 + wid;
    const bf16_t* Q = (const bf16_t*)(ws + WS_QA) + (size_t)bh * SEQ * HD;
    const bf16_t* K = (const bf16_t*)(ws + WS_KA) + (size_t)bh * SEQ * HD;
    const bf16_t* V = (const bf16_t*)(ws + WS_VAT) + (size_t)bh * SEQ * HD;
    {
        const bf16_t* src; size_t tstride; unsigned dstoff;
        { const int w4 = wid & 3, row = 8 * w4 + (lane >> 3), pc = lane & 7, lc = pc ^ ((row >> 1) & 7);
          src = (wid < 4 ? K : V) + (size_t)(row * d + r) * HD + lc * 8; tstride = (size_t)32 * d * HD; dstoff = (wid < 4 ? 0 : 4096) + w4 * 1024; }
#pragma unroll
        for (int j = 0; j < 12; ++j) { const int jt = ib0 - 4 + j;
            if (jt >= 0) __builtin_amdgcn_global_load_lds((const unsigned*)(src + (size_t)jt * tstride), (LAS unsigned*)(lds + j * 8192 + dstoff), 16, 0, 0); }
    }
    const int iq = 32 * ib + i32, tq = iq * d + r;
    bf16x8 qf[4];
#pragma unroll
    for (int kk = 0; kk < 4; ++kk) qf[kk] = *(const bf16x8*)(Q + (size_t)tq * HD + 16 * kk + 8 * hi);
    int koff[4], toff[2][2][2];
    { const int rho = kvmap(i32);
#pragma unroll
      for (int kk = 0; kk < 4; ++kk) koff[kk] = rho * 128 + (((2 * kk + hi) ^ ((rho >> 1) & 7)) << 4); }
    tr_offsets(lane, toff);
    asm volatile("s_waitcnt vmcnt(0)\n\ts_barrier" ::: "memory");
    FA2 st; fa2_init(st);
    auto tile_mask = [&](int jj2, int jt2) -> unsigned { unsigned vm = 0xffffu;
        if (jj2 == 0 || jj2 == 4) { vm = 0;
#pragma unroll
            for (int rr = 0; rr < 16; ++rr) { const int ik = 32 * jt2 + kvl_of(rr, hi); vm |= ((ik <= iq) && (iq - ik <= 128)) ? (1u << rr) : 0u; } }
        return vm; };
    int jj = (ib - 4 < 0) ? 4 - ib : 0;
#pragma unroll 1
    for (; jj + 1 < 5; jj += 2) {
        const LAS unsigned char* sA = lds + (wid + jj) * 8192; const LAS unsigned char* sB = sA + 8192;
        bf16x8 kA[4], kB[4];
#pragma unroll
        for (int kk = 0; kk < 4; ++kk) { kA[kk] = *(const LAS bf16x8*)(sA + koff[kk]); kB[kk] = *(const LAS bf16x8*)(sB + koff[kk]); }
        const unsigned vmA = tile_mask(jj, ib - 4 + jj), vmB = tile_mask(jj + 1, ib - 3 + jj);
        fa2_pair_latev(st, kA, sA + 4096, kB, sB + 4096, toff, qf, true, jj == 0, vmA, jj + 1 == 4, vmB);
    }
    if (jj < 5) {
        const int jt = ib - 4 + jj;
        const LAS unsigned char* stg = lds + (wid + jj) * 8192;
        bf16x8 kf[4], vf[2][2];
#pragma unroll
        for (int kk = 0; kk < 4; ++kk) kf[kk] = *(const LAS bf16x8*)(stg + koff[kk]);
        read_v_tr(stg + 4096, toff, vf);
        fa2_step(st, kf, vf, qf, true, (jj == 0 || jj == 4), tile_mask(jj, jt));
    }
    const float l = st.l + __shfl_xor(st.l, 32);
    const int b = bh >> 3, h = bh & 7;
    const size_t tok = (size_t)b * SEQ + tq;
    store_o((bf16_t*)(ws + WS_OP) + ((size_t)p * MROWS + tok) * 512 + h * HD, st.o0, st.o1, 1.0f / l, hi);
    if (hi == 0) ((float*)(ws + WS_LSE))[((size_t)p * MROWS + tok) * 8 + h] = LN2F * (st.mref + __log2f(l));
    asm volatile("s_waitcnt lgkmcnt(0)\n\ts_barrier" ::: "memory");
}

constexpr int NSA_RING = 0, NSA_NS = 16, NSA_D = 8, NSA_UW = 140 * 1024;
DI void nsa_unit(unsigned char* ws, LAS unsigned char* lds, int unit) {
    int tid = threadIdx.x; asm volatile("" : "+v"(tid));
    const int lane = tid & 63, wid = __builtin_amdgcn_readfirstlane(tid >> 6), i32 = lane & 31, hi = lane >> 5;
    const int qt = 127 - (unit >> 3), bg = unit & 7, b = bg >> 1, g = bg & 1;
    LAS float* impA = (LAS float*)lds; LAS float* impC = impA + 64 * 128; LAS unsigned short* sel16 = (LAS unsigned short*)(impC + 64 * 128);
    const int ql = 8 * wid + (i32 >> 2), hh = i32 & 3, t = 64 * qt + ql, head = g * 4 + hh;
    bf16x8 qf[4];
    { const bf16_t* Q = (const bf16_t*)(ws + WS_QB) + ((size_t)(b * NHB + head) * SEQ + t) * HD;
#pragma unroll
      for (int kk = 0; kk < 4; ++kk) qf[kk] = *(const bf16x8*)(Q + 16 * kk + 8 * hi); }
    const float* gp = (const float*)(ws + WS_GATES) + ((size_t)b * SEQ + t) * 24 + head * 3;
    const float g_cmp = gp[0], g_slc = gp[1], g_win = gp[2];
    f32x16 a0, a1;
#pragma unroll
    for (int r = 0; r < 16; ++r) { a0[r] = 0.f; a1[r] = 0.f; }
    const int t_lo_w = 64 * qt + 8 * wid, t_hi_w = t_lo_w + 7;
    const bf16_t* KCC = (const bf16_t*)(ws + WS_KCC) + (size_t)bg * NCP * HD;
    const bf16_t* VCCT = (const bf16_t*)(ws + WS_VCCT) + (size_t)bg * HD * NCP;
    const int nvis = t >= 31 ? ((t - 31) >> 4) + 1 : 0;
    const int nvis_w = t_hi_w >= 31 ? ((t_hi_w - 31) >> 4) + 1 : 0, ntile = (nvis_w + 31) >> 5;
    const int nvis_lo = t_lo_w >= 31 ? ((t_lo_w - 31) >> 4) + 1 : 0;
    float mc, invc;
    int koff[4], voff[2][2];
    { const int rho = kvmap(i32);
#pragma unroll
      for (int kk = 0; kk < 4; ++kk) koff[kk] = rho * 128 + (((2 * kk + hi) ^ ((rho >> 1) & 7)) << 4);
#pragma unroll
      for (int db = 0; db < 2; ++db)
#pragma unroll
          for (int ks = 0; ks < 2; ++ks) { const int row = 32 * db + i32; voff[db][ks] = row * 64 + (((2 * ks + hi) ^ ((row >> 2) & 3)) << 4); } }
    unsigned srcoff, dstoff;
    if (wid < 4) { const int row = 8 * wid + (lane >> 3), pc = lane & 7, lc = pc ^ ((row >> 1) & 7); srcoff = row * 64 + lc * 8; dstoff = wid * 1024; }
    else { const int v = wid - 4, row = 16 * v + (lane >> 2), pc = lane & 3, lc = pc ^ ((row >> 2) & 3); srcoff = row * 32 + lc * 8; dstoff = (wid - 4) * 1024; }
    {
        const int t_hi_b = 64 * qt + 63, nvis_b = t_hi_b >= 31 ? ((t_hi_b - 31) >> 4) + 1 : 0, ntile_b = (nvis_b + 31) >> 5;
        const bf16_t* cbase = (wid < 4 ? KCC : VCCT) + srcoff; const unsigned cdst = (wid < 4 ? 65536u : 0u) + dstoff;
#pragma unroll 1
        for (int j = 0; j < ntile_b; ++j) __builtin_amdgcn_global_load_lds((const unsigned*)(cbase + (size_t)j * 2048), (LAS unsigned*)(lds + cdst + j * 4096), 16, 0, 0);
        asm volatile("s_waitcnt vmcnt(0)\n\ts_barrier" ::: "memory");
        FA2 st; fa2_init(st);
#pragma unroll 1
        for (int jt = 0; jt < ntile; ++jt) {
            bf16x8 kf[4], vf[2][2];
#pragma unroll
            for (int kk = 0; kk < 4; ++kk) kf[kk] = *(const LAS bf16x8*)(lds + 65536 + jt * 4096 + koff[kk]);
#pragma unroll
            for (int db = 0; db < 2; ++db)
#pragma unroll
                for (int ks = 0; ks < 2; ++ks) vf[db][ks] = *(const LAS bf16x8*)(lds + jt * 4096 + voff[db][ks]);
            const bool nm = 32 * jt + 32 > nvis_lo; unsigned vm = 0xffffu;
            if (nm) { vm = 0;
#pragma unroll
                for (int rr = 0; rr < 16; ++rr) vm |= (32 * jt + kvl_of(rr, hi) < nvis) ? (1u << rr) : 0u; }
            fa2_step(st, kf, vf, qf, true, nm, vm);
        }
        const float l = st.l + __shfl_xor(st.l, 32);
        invc = l > 0.f ? 1.0f / l : 0.f; mc = st.mref;
        const float sc = g_cmp * invc;
#pragma unroll
        for (int r = 0; r < 16; ++r) { a0[r] += sc * st.o0[r]; a1[r] += sc * st.o1[r]; }
    }
    asm volatile("s_waitcnt lgkmcnt(0)\n\ts_barrier" ::: "memory");
#pragma unroll
    for (int k = 0; k < 16; ++k) { impA[(8 * wid) * 128 + lane + 64 * k] = 0.f; impC[(8 * wid) * 128 + lane + 64 * k] = 0.f; }
    {
        const f32x16 cm = splat16(-mc);
#pragma unroll 1
        for (int jt = 0; jt < ntile; ++jt) {
            bf16x8 kf[4];
#pragma unroll
            for (int kk = 0; kk < 4; ++kk) kf[kk] = *(const LAS bf16x8*)(lds + 65536 + jt * 4096 + koff[kk]);
            f32x16 s = MFMA32(kf[0], qf[0], cm);
            s = MFMA32(kf[1], qf[1], s); s = MFMA32(kf[2], qf[2], s); s = MFMA32(kf[3], qf[3], s);
#pragma unroll
            for (int rr = 0; rr < 16; ++rr) {
                float p = (32 * jt + kvl_of(rr, hi) < nvis) ? __builtin_amdgcn_exp2f(s[rr]) * invc : 0.f;
                p += dppf<0xB1>(p); p += dppf<0x4E>(p);
                s[rr] = p;
            }
            if (hh == 0) {
#pragma unroll
                for (int grp = 0; grp < 4; ++grp) {
                    const int r0 = 4 * grp, sb = 8 * jt + 4 * (r0 >> 3) + 2 * hi + ((r0 & 7) >> 2);
                    impA[ql * 128 + sb] = s[r0] + s[r0 + 1] + s[r0 + 2] + 0.5f * s[r0 + 3];
                    impC[ql * 128 + sb] = 0.5f * s[r0 + 3];
                }
            }
        }
    }
    __syncthreads();
    {
        const int q2 = tid >> 3, part = tid & 7;
        unsigned key[16];
#pragma unroll
        for (int k = 0; k < 16; ++k) {
            const int s = 16 * part + k;
            const bool forced = (s == qt) || (s == qt - 1) || (s == 0);
            const bool valid = s <= qt;
            const float imp = impA[q2 * 128 + s] + (s > 0 ? impC[q2 * 128 + s - 1] : 0.f);
            const float scv = forced ? 1e9f : (valid ? imp : -1e9f);
            const unsigned ub = __builtin_bit_cast(unsigned, scv);
            key[k] = (ub & 0x80000000u) ? ~ub : (ub | 0x80000000u);
        }
        unsigned thr = 0u;
#pragma unroll 1
        for (int bit = 31; bit >= 0; --bit) {
            const unsigned cand = thr | (1u << bit);
            int c = 0;
#pragma unroll
            for (int k = 0; k < 16; ++k) c += (key[k] >= cand) ? 1 : 0;
            c = sum8(c);
            if (c >= 16) thr = cand;
        }
        int ngt = 0, neq = 0;
#pragma unroll
        for (int k = 0; k < 16; ++k) { ngt += (key[k] > thr) ? 1 : 0; neq += (key[k] == thr) ? 1 : 0; }
        int tg = sum8(ngt);
        int incl = neq;
        { int v = __shfl_up(incl, 1); if (part >= 1) incl += v; v = __shfl_up(incl, 2); if (part >= 2) incl += v; v = __shfl_up(incl, 4); if (part >= 4) incl += v; }
        int eq_before = incl - neq;
        const int quota = 16 - tg;
        unsigned bits = 0;
#pragma unroll
        for (int k = 0; k < 16; ++k) {
            bool take = key[k] > thr;
            if (key[k] == thr) { take = eq_before < quota; ++eq_before; }
            bits |= (take && (16 * part + k) <= qt) ? (1u << k) : 0u;
        }
        sel16[q2 * 8 + part] = (unsigned short)bits;
    }
    __syncthreads();
    {
        const LAS unsigned* selw = (const LAS unsigned*)sel16 + ql * 4;
        const unsigned s0 = selw[0], s1 = selw[1], s2 = selw[2], s3 = selw[3];
        __syncthreads();
        const bf16_t* KS = (const bf16_t*)(ws + WS_KS) + (size_t)bg * SEQ * HD;
        const bf16_t* VST = (const bf16_t*)(ws + WS_VST) + (size_t)bg * SEQ * HD;
        const bf16_t* KW = (const bf16_t*)(ws + WS_KW) + (size_t)bg * SEQ * HD;
        const bf16_t* VWT = (const bf16_t*)(ws + WS_VWT) + (size_t)bg * SEQ * HD;
        const int T_s = 2 * qt + 2;
        const int w_lo = (64 * qt - 512 < 0 ? 0 : 64 * qt - 512) >> 5, T_w = 2 * qt + 2 - w_lo, T = T_s + T_w;
        unsigned rsrc, rdst;
        { const int w4 = wid & 3, row = 8 * w4 + (lane >> 3), pc = lane & 7, lc = pc ^ ((row >> 1) & 7); rsrc = row * 64 + lc * 8; rdst = (wid < 4 ? 0u : 4096u) + w4 * 1024; }
        int toff[2][2][2]; tr_offsets(lane, toff);
        const bf16_t* base_s = (wid < 4) ? KS : VST; const bf16_t* base_w = (wid < 4) ? KW : VWT;
#define NSA_ISSUE(n_) do { const int n__ = (n_); const bool isw__ = n__ >= T_s; const int tile__ = isw__ ? (w_lo + n__ - T_s) : n__; \
            const bf16_t* src__ = (isw__ ? base_w : base_s) + (size_t)tile__ * 2048 + rsrc; \
            __builtin_amdgcn_global_load_lds((const unsigned*)src__, (LAS unsigned*)(lds + NSA_RING + (n__ & (NSA_NS - 1)) * 8192 + rdst), 16, 0, 0); } while (0)
#pragma unroll
        for (int n = 0; n < NSA_D; ++n) if (n < T) NSA_ISSUE(n);
        FA2 st; fa2_init(st);
        bool sel = true;
#pragma unroll 1
        for (int n = 0; n < T; n += 8) {
            const int after = 0;
            if (after >= 8) asm volatile("s_waitcnt vmcnt(8)" ::: "memory");
            else if (after == 6) asm volatile("s_waitcnt vmcnt(6)" ::: "memory");
            else if (after == 4) asm volatile("s_waitcnt vmcnt(4)" ::: "memory");
            else if (after == 2) asm volatile("s_waitcnt vmcnt(2)" ::: "memory");
            else asm volatile("s_waitcnt vmcnt(0)" ::: "memory");
            asm volatile("s_barrier" ::: "memory");
#pragma unroll
            for (int k = 0; k < 8; ++k) if (n + NSA_D + k < T) NSA_ISSUE(n + NSA_D + k);
#pragma unroll 1
            for (int np = n; np < n + 8 && np < T; np += 2) {
                if (np == T_s) {
                    const float l = st.l + __shfl_xor(st.l, 32);
                    const float sc = g_slc / l;
#pragma unroll
                    for (int r = 0; r < 16; ++r) { a0[r] += sc * st.o0[r]; a1[r] += sc * st.o1[r]; }
                    fa2_init(st); sel = true;
                }
                bool active = true;
                if (np < T_s) {
                    const int jb = np >> 1;
                    const unsigned w = jb < 32 ? s0 : (jb < 64 ? s1 : (jb < 96 ? s2 : s3));
                    sel = (w >> (jb & 31)) & 1u;
                    active = __any(sel);
                }
                if (active) {
                    const LAS unsigned char* sgA = lds + NSA_RING + (np & (NSA_NS - 1)) * 8192;
                    const LAS unsigned char* sgB = lds + NSA_RING + ((np + 1) & (NSA_NS - 1)) * 8192;
                    bf16x8 kA[4], kB[4];
#pragma unroll
                    for (int kk = 0; kk < 4; ++kk) { kA[kk] = *(const LAS bf16x8*)(sgA + koff[kk]); kB[kk] = *(const LAS bf16x8*)(sgB + koff[kk]); }
                    bool nmA, nmB; unsigned vmA = 0xffffu, vmB = 0xffffu;
                    if (np < T_s) {
                        nmA = nmB = (np >> 1) == qt;
                        if (nmA) { vmA = 0; vmB = 0;
#pragma unroll
                            for (int rr = 0; rr < 16; ++rr) { vmA |= (32 * np + kvl_of(rr, hi) <= t) ? (1u << rr) : 0u; vmB |= (32 * np + 32 + kvl_of(rr, hi) <= t) ? (1u << rr) : 0u; } }
                    } else {
                        const int kv0 = 32 * (w_lo + np - T_s);
                        nmA = !(kv0 >= t_hi_w - 511 && kv0 + 31 <= t_lo_w);
                        nmB = !(kv0 + 32 >= t_hi_w - 511 && kv0 + 63 <= t_lo_w);
                        if (nmA) { vmA = 0;
#pragma unroll
                            for (int rr = 0; rr < 16; ++rr) { const int k = kv0 + kvl_of(rr, hi); vmA |= ((k <= t) && (t - k < 512)) ? (1u << rr) : 0u; } }
                        if (nmB) { vmB = 0;
#pragma unroll
                            for (int rr = 0; rr < 16; ++rr) { const int k = kv0 + 32 + kvl_of(rr, hi); vmB |= ((k <= t) && (t - k < 512)) ? (1u << rr) : 0u; } }
                    }
                    fa2_pair_latev(st, kA, sgA + 4096, kB, sgB + 4096, toff, qf, sel, nmA, vmA, nmB, vmB);
                }
            }
        }
        const float l = st.l + __shfl_xor(st.l, 32);
        const float sc = g_win / l;
#pragma unroll
        for (int r = 0; r < 16; ++r) { a0[r] += sc * st.o0[r]; a1[r] += sc * st.o1[r]; }
    }
    store_o((bf16_t*)(ws + WS_CAT) + ((size_t)b * SEQ + t) * DM + 512 + head * HD, a0, a1, 1.0f, hi);
}

struct Args { const float* in[19]; float* out; unsigned char* ws; };
enum { I_X = 0, I_C, I_WADA, I_BADA, I_WIN, I_PE, I_WCK1, I_WCK2, I_WCV1, I_WCV2, I_WO, I_LN1G, I_LN1B, I_WUP, I_CONVW, I_CONVB, I_WDOWN, I_LN2G, I_LN2B };

template <int MODE> DI int maprow(int n) { if (MODE == 1) { return n < FF ? 256 * (n >> 7) + (n & 127) : 256 * ((n - FF) >> 7) + 128 + ((n - FF) & 127); } return n; }
template <int MODE> DI void tr_item(const float* W, int K, int N, bf16_t* WT, LAS float* scr, int item, int lane) {
    const int nblk = (N + 31) / 32, kb = item / nblk, nb = item % nblk, k0 = 64 * kb, n0 = 32 * nb;
    const int nn = n0 + (lane & 31);
#pragma unroll
    for (int i = 0; i < 32; ++i) { const int kk = 2 * i + (lane >> 5); scr[kk * 33 + (lane & 31)] = nn < N ? W[(size_t)(k0 + kk) * N + nn] : 0.f; }
    asm volatile("s_waitcnt lgkmcnt(0)" ::: "memory");
    const int c = lane & 7;
#pragma unroll
    for (int j = 0; j < 4; ++j) { const int nl = (lane >> 3) + 8 * j, n = n0 + nl; const LAS float* s = scr + (8 * c) * 33 + nl;
        u32x4 o; o.x = pk2(s[0 * 33], s[1 * 33]); o.y = pk2(s[2 * 33], s[3 * 33]); o.z = pk2(s[4 * 33], s[5 * 33]); o.w = pk2(s[6 * 33], s[7 * 33]);
        if (n < N) *(u32x4*)(WT + (size_t)maprow<MODE>(n) * K + k0 + 8 * c) = o; }
    asm volatile("s_waitcnt lgkmcnt(0)" ::: "memory");
}
template <int MODE> DI void tr_matrix(const float* W, int K, int N, bf16_t* WT, LAS float* scr, int gw, int ngw, int lane) {
    const int nitems = (K / 64) * ((N + 31) / 32);
    for (int it = gw; it < nitems; it += ngw) tr_item<MODE>(W, K, N, WT, scr, it, lane);
}

DI void phase0(const Args& a, LAS unsigned char* lds) {
    unsigned char* ws = a.ws;
    const int tid = threadIdx.x, lane = tid & 63, wid = tid >> 6, G = gridDim.x, bx = blockIdx.x;
    if (bx == 0 && tid < 16) ((unsigned*)(ws + WS_CTR))[tid] = 0u;
    if (bx == 0) for (int i = tid; i < 3456; i += 512) ((unsigned*)(ws + WS_BAR))[i] = 0u;
    {
        LAS float* red = (LAS float*)lds;
        const float* c = a.in[I_C]; const float* W = a.in[I_WADA];
        LAS float* sl = (LAS float*)(lds + 16384);
        if (bx < 192) { for (int i = tid; i < 4096; i += 512) { const float cv = c[i]; sl[i] = cv / (1.f + __expf(-cv)); } __syncthreads(); }
        for (int it = bx; it < 192; it += G) {
            const int col = it * 32 + (tid & 31), kc = tid >> 5;
            float s0 = 0.f, s1 = 0.f, s2 = 0.f, s3 = 0.f;
#pragma unroll 16
            for (int k = kc * 64; k < kc * 64 + 64; ++k) {
                const float w = W[(size_t)k * 6144 + col];
                s0 += w * sl[k]; s1 += w * sl[1024 + k]; s2 += w * sl[2048 + k]; s3 += w * sl[3072 + k];
            }
            red[(kc * 4 + 0) * 32 + (tid & 31)] = s0; red[(kc * 4 + 1) * 32 + (tid & 31)] = s1; red[(kc * 4 + 2) * 32 + (tid & 31)] = s2; red[(kc * 4 + 3) * 32 + (tid & 31)] = s3;
            __syncthreads();
            if (tid < 128) { const int bb = tid >> 5, cc = tid & 31; float s = 0.f;
#pragma unroll
                for (int k = 0; k < 16; ++k) s += red[(k * 4 + bb) * 32 + cc];
                ((float*)(ws + WS_MOD))[bb * 6144 + it * 32 + cc] = s + a.in[I_BADA][it * 32 + cc]; }
            __syncthreads();
        }
        for (int it = (G >= 208 ? bx - 192 : bx); it >= 0 && it < 16; it += G) {
            const int z = it >> 3, col = (it & 7) * 32 + (tid & 31), kc = tid >> 5;
            const float* W1 = a.in[z ? I_WCV1 : I_WCK1]; const float* pe = a.in[I_PE];
            float s = 0.f;
#pragma unroll 32
            for (int k = kc * 128; k < kc * 128 + 128; ++k) s += pe[k] * W1[(size_t)k * 256 + col];
            red[kc * 32 + (tid & 31)] = s;
            __syncthreads();
            if (tid < 32) { float t = 0.f;
#pragma unroll
                for (int k = 0; k < 16; ++k) t += red[k * 32 + tid];
                ((float*)(ws + WS_CB))[z * 256 + (it & 7) * 32 + tid] = t; }
            __syncthreads();
        }
    }
    for (int idx = bx * 512 + tid; idx < SEQ * 8; idx += G * 512) {
        const int pos = idx >> 3, i = idx & 7;
        const double inv = exp(-log(500000.0) * (double)i / 8.0);
        const float ang = (float)pos * (float)inv;
        double sn, cs; sincos((double)ang, &sn, &cs);
        ((f32x2*)(ws + WS_ROPE))[idx] = (f32x2){(float)cs, (float)sn};
    }
    {
        LAS float* scr = (LAS float*)(lds + 8192) + wid * (64 * 33);
        const int gw = bx * 8 + wid, ngw = G * 8;
        tr_matrix<0>(a.in[I_WIN], DM, NIN, (bf16_t*)(ws + WS_WIN), scr, gw, ngw, lane);
        tr_matrix<0>(a.in[I_WO], DM, DM, (bf16_t*)(ws + WS_WO), scr, gw, ngw, lane);
        tr_matrix<1>(a.in[I_WUP], DM, NUP, (bf16_t*)(ws + WS_WUP), scr, gw, ngw, lane);
        tr_matrix<0>(a.in[I_WDOWN], FF, DM, (bf16_t*)(ws + WS_WDN), scr, gw, ngw, lane);
        tr_matrix<0>(a.in[I_WCK1], 2048, 256, (bf16_t*)(ws + WS_WC1), scr, gw, ngw, lane);
        tr_matrix<0>(a.in[I_WCV1], 2048, 256, (bf16_t*)(ws + WS_WC1) + 256 * 2048, scr, gw, ngw, lane);
        tr_matrix<0>(a.in[I_WCK2], 256, 64, (bf16_t*)(ws + WS_W2C), scr, gw, ngw, lane);
        tr_matrix<0>(a.in[I_WCV2], 256, 64, (bf16_t*)(ws + WS_W2C) + 64 * 256, scr, gw, ngw, lane);
        u32x4* z = (u32x4*)((bf16_t*)(ws + WS_WIN) + (size_t)NIN * DM);
        const int nz = (NINP - NIN) * DM / 8;
        for (int i = bx * 512 + tid; i < nz; i += G * 512) z[i] = (u32x4){0u, 0u, 0u, 0u};
    }
}

DI void row_load(const float* p, int lane, f32x4 (&v)[4]) {
#pragma unroll
    for (int j = 0; j < 4; ++j) v[j] = *(const f32x4*)(p + 4 * lane + 256 * j);
}
DI void row_load_nt(const float* p, int lane, f32x4 (&v)[4]) {
#pragma unroll
    for (int j = 0; j < 4; ++j) v[j] = __builtin_nontemporal_load((const f32x4*)(p + 4 * lane + 256 * j));
}
DI void row_norm(f32x4 (&v)[4]) {
    float s = 0.f;
#pragma unroll
    for (int j = 0; j < 4; ++j) s += (v[j].x + v[j].y) + (v[j].z + v[j].w);
    const float mean = wave_sum(s) * (1.f / DM); float s2 = 0.f;
#pragma unroll
    for (int j = 0; j < 4; ++j) { v[j] = v[j] - mean; s2 += (v[j].x * v[j].x + v[j].y * v[j].y) + (v[j].z * v[j].z + v[j].w * v[j].w); }
    const float rstd = 1.f / sqrtf(wave_sum(s2) * (1.f / DM) + LN_EPS);
#pragma unroll
    for (int j = 0; j < 4; ++j) v[j] = v[j] * rstd;
}
DI void row_mod_store(const f32x4 (&v)[4], const float* sh, const float* sc, bf16_t* o, int lane) {
#pragma unroll
    for (int j = 0; j < 4; ++j) { const f32x4 a = *(const f32x4*)(sc + 4 * lane + 256 * j), b = *(const f32x4*)(sh + 4 * lane + 256 * j);
        const f32x4 r = v[j] * (a + 1.0f) + b; u32x2 w; w.x = pk2(r.x, r.y); w.y = pk2(r.z, r.w); *(u32x2*)(o + 4 * lane + 256 * j) = w; }
}
DI void phase1(const Args& a) {
    const int lane = threadIdx.x & 63, gw = blockIdx.x * 8 + (threadIdx.x >> 6), ngw = gridDim.x * 8;
    const float* mod = (const float*)(a.ws + WS_MOD);
    for (int m0 = gw; m0 < MROWS; m0 += 4 * ngw) {
        f32x4 v[4][4]; bool has[4]; int mr[4];
#pragma unroll
        for (int k = 0; k < 4; ++k) { const int m = m0 + k * ngw; has[k] = m < MROWS; mr[k] = has[k] ? m : m0; row_load_nt(a.in[I_X] + (size_t)mr[k] * DM, lane, v[k]); }
#pragma unroll
        for (int k = 0; k < 4; ++k) row_norm(v[k]);
#pragma unroll
        for (int k = 0; k < 4; ++k) if (has[k]) { const int b = mr[k] >> 13; row_mod_store(v[k], mod + b * 6144 + 0 * 1024, mod + b * 6144 + 1 * 1024, (bf16_t*)(a.ws + WS_U) + (size_t)mr[k] * DM, lane); }
    }
}
DI void row_load_bf16(const bf16_t* p, int lane, f32x4 (&v)[4]) {
#pragma unroll
    for (int j = 0; j < 4; ++j) { const u32x2 w = __builtin_nontemporal_load((const u32x2*)(p + 4 * lane + 256 * j));
        v[j] = (f32x4){bf2f((unsigned short)(w.x & 0xffffu)), bf2f((unsigned short)(w.x >> 16)), bf2f((unsigned short)(w.y & 0xffffu)), bf2f((unsigned short)(w.y >> 16))}; }
}
DI void phase5b(const Args& a) {
    const int lane = threadIdx.x & 63, gw = blockIdx.x * 8 + (threadIdx.x >> 6), ngw = gridDim.x * 8;
    const float* mod = (const float*)(a.ws + WS_MOD); const bf16_t* Y = (const bf16_t*)(a.ws + WS_OP);
    f32x4 gg[4], bb[4]; row_load(a.in[I_LN1G], lane, gg); row_load(a.in[I_LN1B], lane, bb);
    for (int m0 = gw; m0 < MROWS; m0 += 4 * ngw) {
        f32x4 v[4][4]; bool has[4]; int mr[4];
#pragma unroll
        for (int k = 0; k < 4; ++k) { const int m = m0 + k * ngw; has[k] = m < MROWS; mr[k] = has[k] ? m : m0; row_load_nt(a.in[I_X] + (size_t)mr[k] * DM, lane, v[k]); }
#pragma unroll
        for (int k = 0; k < 4; ++k) { f32x4 y[4], g1[4]; row_load_bf16(Y + (size_t)mr[k] * DM, lane, y); row_load(mod + (mr[k] >> 13) * 6144 + 2 * 1024, lane, g1);
#pragma unroll
            for (int j = 0; j < 4; ++j) v[k][j] = v[k][j] * ALPHA + g1[j] * y[j]; }
#pragma unroll
        for (int k = 0; k < 4; ++k) row_norm(v[k]);
#pragma unroll
        for (int k = 0; k < 4; ++k) { float* p = a.out + (size_t)mr[k] * DM;
#pragma unroll
            for (int j = 0; j < 4; ++j) { v[k][j] = v[k][j] * gg[j] + bb[j]; if (has[k]) __builtin_nontemporal_store(v[k][j], (f32x4*)(p + 4 * lane + 256 * j)); } }
#pragma unroll
        for (int k = 0; k < 4; ++k) row_norm(v[k]);
#pragma unroll
        for (int k = 0; k < 4; ++k) if (has[k]) { const int b = mr[k] >> 13; row_mod_store(v[k], mod + b * 6144 + 3 * 1024, mod + b * 6144 + 4 * 1024, (bf16_t*)(a.ws + WS_U) + (size_t)mr[k] * DM, lane); }
    }
}
DI void phase7b(const Args& a) {
    const int lane = threadIdx.x & 63, gw = blockIdx.x * 8 + (threadIdx.x >> 6), ngw = gridDim.x * 8;
    const float* mod = (const float*)(a.ws + WS_MOD); const bf16_t* Z = (const bf16_t*)(a.ws + WS_U);
    f32x4 gg[4], bb[4]; row_load(a.in[I_LN2G], lane, gg); row_load(a.in[I_LN2B], lane, bb);
    for (int m0 = gw; m0 < MROWS; m0 += 4 * ngw) {
        f32x4 v[4][4]; bool has[4]; int mr[4];
#pragma unroll
        for (int k = 0; k < 4; ++k) { const int m = m0 + k * ngw; has[k] = m < MROWS; mr[k] = has[k] ? m : m0; row_load_nt(a.out + (size_t)mr[k] * DM, lane, v[k]); }
#pragma unroll
        for (int k = 0; k < 4; ++k) { f32x4 y[4], g2[4]; row_load_bf16(Z + (size_t)mr[k] * DM, lane, y); row_load(mod + (mr[k] >> 13) * 6144 + 5 * 1024, lane, g2);
#pragma unroll
            for (int j = 0; j < 4; ++j) v[k][j] = v[k][j] * ALPHA + g2[j] * y[j]; }
#pragma unroll
        for (int k = 0; k < 4; ++k) row_norm(v[k]);
#pragma unroll
        for (int k = 0; k < 4; ++k) if (has[k]) { float* p = a.out + (size_t)mr[k] * DM;
#pragma unroll
            for (int j = 0; j < 4; ++j) __builtin_nontemporal_store(v[k][j] * gg[j] + bb[j], (f32x4*)(p + 4 * lane + 256 * j)); }
    }
}

DI void compress_unit(const Args& a, LAS unsigned char* lds, int cu) {
    unsigned char* ws = a.ws;
    const int z = cu >> 4, pm = cu & 15;
    bf16_t* HID = (bf16_t*)(ws + WS_HID) + (size_t)z * 4096 * 256;
    {
        pg8::Gemm g{(const bf16_t*)(ws + (z ? WS_VC : WS_KC)), (const bf16_t*)(ws + WS_WC1) + (size_t)z * 256 * 2048, 4096, 256, 2048, 1024};
        pg8::OneUnit S{pm};
        EpiHid E{HID, (const float*)(ws + WS_CB) + z * 256};
        pg8::gemm_phase<EpiHid, pg8::OneUnit>(lds, g, S, E);
    }
    __threadfence(); __syncthreads();
    const int tid = threadIdx.x, lane = tid & 63, wid = tid >> 6, i32 = lane & 31, hi = lane >> 5;
    const int row = pm * 256 + wid * 32 + i32;
    const bf16_t* W2T = (const bf16_t*)(ws + WS_W2C) + (size_t)z * 64 * 256;
    f32x16 o0, o1;
#pragma unroll
    for (int r = 0; r < 16; ++r) { o0[r] = 0.f; o1[r] = 0.f; }
#pragma unroll 4
    for (int ks = 0; ks < 16; ++ks) {
        const bf16x8 bf = *(const bf16x8*)(HID + (size_t)row * 256 + 16 * ks + 8 * hi);
        const bf16x8 w0 = *(const bf16x8*)(W2T + (size_t)i32 * 256 + 16 * ks + 8 * hi);
        const bf16x8 w1 = *(const bf16x8*)(W2T + (size_t)(32 + i32) * 256 + 16 * ks + 8 * hi);
        o0 = MFMA32(w0, bf, o0); o1 = MFMA32(w1, bf, o1);
    }
    const int bg = row >> 9, n = row & 511;
    if (z == 0) {
        store_o((bf16_t*)(ws + WS_KCC) + ((size_t)bg * NCP + n) * HD, o0, o1, 1.0f, hi);
    } else {
        bf16_t* vt = (bf16_t*)(ws + WS_VCCT) + (size_t)bg * HD * NCP + (size_t)(n >> 5) * 2048 + (n & 31);
#pragma unroll
        for (int r = 0; r < 16; ++r) { const int d = (r & 3) + 8 * (r >> 2) + 4 * hi; vt[d * 32] = (bf16_t)f2bf(o0[r]); vt[(32 + d) * 32] = (bf16_t)f2bf(o1[r]); }
    }
    __syncthreads();
}

DI void phase3(const Args& a, LAS unsigned char* lds, int cidx = 0) {
    for (int cu = blockIdx.x; cu < 32; cu += gridDim.x) compress_unit(a, lds, cu);
    unsigned* ctr = (unsigned*)(a.ws + WS_CTR) + cidx;
    LAS unsigned* uw = (LAS unsigned*)(lds + 100 * 1024);
    if (threadIdx.x == 0) uw[0] = atomicAdd(ctr, 1u);
    __syncthreads();
    for (;;) {
        const unsigned u = uw[0];
        __syncthreads();
        if (u >= 3072u) break;
        if (threadIdx.x == 0) uw[0] = atomicAdd(ctr, 1u);
        dilated_block_unit(a.ws, lds, (int)u);
    }
}

DI void phase4(const Args& a, LAS unsigned char* lds, int cidx = 1) {
    unsigned* ctr = (unsigned*)(a.ws + WS_CTR) + cidx;
    LAS unsigned* uw = (LAS unsigned*)(lds + NSA_UW);
    if (gridDim.x == 256) {
        const int bg = blockIdx.x & 7, j = blockIdx.x >> 3;
#pragma unroll 1
        for (int i = 0; i < 4; ++i) {
            const int qt = (i == 0) ? 127 - j : (i == 1) ? 64 + j : (i == 2) ? 63 - j : j;
            nsa_unit(a.ws, lds, (127 - qt) * 8 + bg);
            __syncthreads();
        }
    } else
    for (;;) {
        if (threadIdx.x == 0) uw[0] = atomicAdd(ctr, 1u);
        __syncthreads();
        const unsigned u = uw[0];
        __syncthreads();
        if (u >= 1024u) break;
        nsa_unit(a.ws, lds, (int)u);
    }
    const int lane = threadIdx.x & 63, gw = blockIdx.x * 8 + (threadIdx.x >> 6), ngw = gridDim.x * 8;
    const float* LSE = (const float*)(a.ws + WS_LSE); const bf16_t* OP = (const bf16_t*)(a.ws + WS_OP); bf16_t* CAT = (bf16_t*)(a.ws + WS_CAT);
    for (int tok = gw; tok < MROWS; tok += ngw) {
        const int h = lane >> 3;
        const float l0 = LSE[(size_t)tok * 8 + h], l1 = LSE[((size_t)MROWS + tok) * 8 + h], l2 = LSE[((size_t)2 * MROWS + tok) * 8 + h];
        const float mx = fmaxf(l0, fmaxf(l1, l2));
        float w0 = __expf(l0 - mx), w1 = __expf(l1 - mx), w2 = __expf(l2 - mx); const float inv = 1.f / (w0 + w1 + w2); w0 *= inv; w1 *= inv; w2 *= inv;
        const u32x4 x0 = *(const u32x4*)(OP + (size_t)tok * 512 + 8 * lane), x1 = *(const u32x4*)(OP + ((size_t)MROWS + tok) * 512 + 8 * lane), x2 = *(const u32x4*)(OP + ((size_t)2 * MROWS + tok) * 512 + 8 * lane);
        u32x4 o;
#pragma unroll
        for (int k = 0; k < 4; ++k) {
            const float lo = w0 * bf2f((unsigned short)(x0[k] & 0xffffu)) + w1 * bf2f((unsigned short)(x1[k] & 0xffffu)) + w2 * bf2f((unsigned short)(x2[k] & 0xffffu));
            const float hi = w0 * bf2f((unsigned short)(x0[k] >> 16)) + w1 * bf2f((unsigned short)(x1[k] >> 16)) + w2 * bf2f((unsigned short)(x2[k] >> 16));
            o[k] = pk2(lo, hi);
        }
        *(u32x4*)(CAT + (size_t)tok * DM + 8 * lane) = o;
    }
}

DI void phase6b(const Args& a) {
    const float* edge = (const float*)(a.ws + WS_EDGE); const float* fixg = (const float*)(a.ws + WS_FIXG); const float* fixv = (const float*)(a.ws + WS_FIXV);
    const float* cw = a.in[I_CONVW]; bf16_t* H = (bf16_t*)(a.ws + WS_H);
    const int total = 128 * 2 * FF;
    for (int idx = blockIdx.x * 512 + threadIdx.x; idx < total; idx += gridDim.x * 512) {
        const int f = idx % FF, rr = (idx / FF) & 1, pm = idx / (2 * FF);
        if ((pm & 31) == 0) continue;
        float gpre = fixg[((size_t)pm * 2 + rr) * FF + f];
        const float e0 = edge[((size_t)(pm - 1) * 2 + 0) * FF + f], e1 = edge[((size_t)(pm - 1) * 2 + 1) * FF + f];
        if (rr == 0) gpre += cw[f] * e0 + cw[FF + f] * e1; else gpre += cw[f] * e1;
        H[(size_t)(pm * 256 + rr) * FF + f] = (bf16_t)f2bf(gelu_tanh(gpre) * fixv[((size_t)pm * 2 + rr) * FF + f]);
    }
}


#define XB_TMO      128
#define XB_XCNT(j)  (256  + 64 * (j))
#define XB_XSUB(j)  (1280 + 64 * (j))
#define XB_XGEN(j)  (2304 + 64 * (j))
#define XB_TOP      3328
#define XB_TOPGEN   3392
#define XCD_BAR_WORDS 3456
#define XB_SPIN_CAP (1u << 22)
DI unsigned xb_ld(unsigned* p)              { return __hip_atomic_load(p, __ATOMIC_RELAXED, __HIP_MEMORY_SCOPE_AGENT); }
DI unsigned xb_add(unsigned* p, unsigned v) { return __hip_atomic_fetch_add(p, v, __ATOMIC_RELAXED, __HIP_MEMORY_SCOPE_AGENT); }
DI unsigned xb_xcc_id() { return (unsigned)__builtin_amdgcn_s_getreg((3 << 11) | 20) & 0xFu; }
#define XB_SPIN(cond, bar) do { unsigned _sp = 0; while (cond) { __builtin_amdgcn_s_sleep(1); \
    if ((++_sp & 255u) == 0u) { if (xb_ld(&(bar)[XB_TMO])) break; if (_sp > XB_SPIN_CAP) { atomicAdd(&(bar)[XB_TMO], 1u); break; } } } } while (0)
struct XcdBarrier { unsigned* bar; unsigned x; volatile LAS unsigned* st; };
DI XcdBarrier xcd_barrier_post(unsigned* bar, volatile LAS unsigned* st) {
    XcdBarrier b; b.bar = bar; b.x = xb_xcc_id(); b.st = st;
    if (threadIdx.x == 0) (void)xb_add(&bar[XB_XCNT(b.x)], 1u);
    return b;
}
DI void xcd_barrier_complete(unsigned* bar, unsigned x, unsigned& nloc, unsigned& nx) {
    const unsigned G = gridDim.x * gridDim.y * gridDim.z;
    unsigned sum, cnt, mine, sp = 0u;
    for (;;) {
        sum = 0u; cnt = 0u; mine = 0u;
#pragma unroll
        for (unsigned j = 0; j < 16; ++j) { const unsigned c = xb_ld(&bar[XB_XCNT(j)]); sum += c; cnt += (c > 0u) ? 1u : 0u; mine = (j == x) ? c : mine; }
        if (sum == G) break;
        __builtin_amdgcn_s_sleep(1);
        if ((++sp & 255u) == 0u) { if (xb_ld(&bar[XB_TMO])) break; if (sp > XB_SPIN_CAP) { atomicAdd(&bar[XB_TMO], 1u); break; } }
    }
    nloc = mine > 0u ? mine : 1u; nx = cnt > 0u ? cnt : 1u;
}
DI void xcd_barrier(const XcdBarrier& b) {
    asm volatile("s_waitcnt vmcnt(0)" ::: "memory");
    __syncthreads();
    if (threadIdx.x == 0) {
        unsigned* bar = b.bar;
        __builtin_amdgcn_s_waitcnt(0);
        unsigned nloc = b.st[0], nx = b.st[1];
        if (nloc == 0u) { xcd_barrier_complete(bar, b.x, nloc, nx); b.st[0] = nloc; b.st[1] = nx; }
        const unsigned old = xb_add(&bar[XB_XSUB(b.x)], 1u);
        const unsigned gen = old / nloc;
        if (old + 1u == (gen + 1u) * nloc) {
            __builtin_amdgcn_fence(__ATOMIC_RELEASE, "agent");
            asm volatile("s_waitcnt vmcnt(0)" ::: "memory");
            const unsigned og = xb_add(&bar[XB_TOP], 1u);
            const unsigned tg = og / nx;
            if (og + 1u == (tg + 1u) * nx) xb_add(&bar[XB_TOPGEN], 1u);
            else XB_SPIN(xb_ld(&bar[XB_TOPGEN]) == tg, bar);
            __builtin_amdgcn_fence(__ATOMIC_ACQUIRE, "agent");
            xb_add(&bar[XB_XGEN(b.x)], 1u);
            asm volatile("s_waitcnt vmcnt(0)" ::: "memory");
        } else {
            XB_SPIN(xb_ld(&bar[XB_XGEN(b.x)]) == gen, bar);
            __builtin_amdgcn_fence(__ATOMIC_ACQUIRE, "agent");
            asm volatile("s_waitcnt vmcnt(0)" ::: "memory");
        }
    }
    __syncthreads();
}

constexpr int LDS_BYTES = 147456;
constexpr int XCH_OFF = 131072;

__global__ void __launch_bounds__(512, 2) mega_fwd(Args a) {
    extern __shared__ __attribute__((aligned(16))) unsigned char lds_raw[];
    LAS unsigned char* lds = (LAS unsigned char*)lds_raw;
    cg::grid_group grid = cg::this_grid();
    if (threadIdx.x < 16) ((LAS unsigned*)(lds + LDS_BYTES - 64))[threadIdx.x] = 0u;
    __syncthreads();
    unsigned char* ws = a.ws;
    const int G = gridDim.x, bx = blockIdx.x;
    const float* mod = (const float*)(ws + WS_MOD);

#ifndef PH_MASK
#define PH_MASK 0xFFFF
#endif
#ifndef REP_P2
#define REP_P2 1
#endif
#ifndef REP_P5
#define REP_P5 1
#endif
#ifndef REP_P6
#define REP_P6 1
#endif
#define PH(k) if (PH_MASK & (1 << (k)))
    PH(0) phase0(a, lds);
#ifdef PROBE_DUP0
    __syncthreads(); phase0(a, lds);
#endif
    grid.sync();
    const XcdBarrier xbar = xcd_barrier_post((unsigned*)(ws + WS_BAR), (volatile LAS unsigned*)(lds + LDS_BYTES - 64));
#ifdef PROBE_SYNC10
    for (int i = 0; i < 10; ++i) xcd_barrier(xbar);
#endif
#ifdef PROBE_DUP6
    PROBE_DUP6_BODY
#endif
    PH(1) phase1(a);
    xcd_barrier(xbar);
    for (int rep = 0; rep < REP_P2; ++rep) {
        pg8::Gemm g{(const bf16_t*)(ws + WS_U), (const bf16_t*)(ws + WS_WIN), MROWS, NINP, DM, DM};
        pg8::StaticOrder S; S.init(MROWS, NINP, G, bx);
        EpiIn E{ws, (const float*)(ws + WS_ROPE)};
        pg8::gemm_phase<EpiIn, pg8::StaticOrder>(lds, g, S, E);
    }
    xcd_barrier(xbar);
    PH(3) phase3(a, lds);
    xcd_barrier(xbar);
#ifdef PROBE_DUP3
    phase3(a, lds, 3);
    xcd_barrier(xbar);
#endif
    PH(4) phase4(a, lds);
    xcd_barrier(xbar);
#ifdef PROBE_DUP4
    phase4(a, lds, 2);
    xcd_barrier(xbar);
#endif
    for (int rep = 0; rep < REP_P5; ++rep) {
        pg8::Gemm g{(const bf16_t*)(ws + WS_CAT), (const bf16_t*)(ws + WS_WO), MROWS, DM, DM, DM};
        pg8::StaticOrder S; S.init(MROWS, DM, G, bx);
        EpiPlain E{(bf16_t*)(ws + WS_OP), DM};
        pg8::gemm_phase<EpiPlain, pg8::StaticOrder>(lds, g, S, E);
    }
    xcd_barrier(xbar);
    PH(6) phase5b(a);
    xcd_barrier(xbar);
    for (int rep = 0; rep < REP_P6; ++rep) {
        pg8::Gemm g{(const bf16_t*)(ws + WS_U), (const bf16_t*)(ws + WS_WUP), MROWS, NUP, DM, DM};
        pg8::StaticOrder S; S.init(MROWS, NUP, G, bx);
        EpiUp E{(bf16_t*)(ws + WS_H), a.in[I_CONVW], a.in[I_CONVB], (float*)(ws + WS_EDGE), (float*)(ws + WS_FIXG), (float*)(ws + WS_FIXV), (LAS float*)(lds + XCH_OFF)};
        pg8::gemm_phase<EpiUp, pg8::StaticOrder>(lds, g, S, E);
    }
    xcd_barrier(xbar);
    PH(8) phase6b(a);
    xcd_barrier(xbar);
    PH(9) {
        pg8::Gemm g{(const bf16_t*)(ws + WS_H), (const bf16_t*)(ws + WS_WDN), MROWS, DM, FF, FF};
        pg8::StaticOrder S; S.init(MROWS, DM, G, bx);
        EpiPlain E{(bf16_t*)(ws + WS_U), DM};
        pg8::gemm_phase<EpiPlain, pg8::StaticOrder>(lds, g, S, E);
    }
    xcd_barrier(xbar);
    PH(10) phase7b(a);
}

extern "C" void kernel_launch(void* const* d_in, const int* in_sizes, int n_in, void* d_out, int out_size, void* d_ws, size_t ws_size, hipStream_t stream) {
    static int grid = 0;
    if (grid == 0) {
        if (n_in != 19 || out_size != MROWS * DM || ws_size < WS_END) { fprintf(stderr, "kernel_launch: unexpected shapes (n_in %d out %d ws %zu)\n", n_in, out_size, ws_size); grid = -1; return; }
        int dev = 0, cus = 0, per_cu = 0;
        (void)hipGetDevice(&dev);
        (void)hipDeviceGetAttribute(&cus, hipDeviceAttributeMultiprocessorCount, dev);
        if (hipFuncSetAttribute((const void*)mega_fwd, hipFuncAttributeMaxDynamicSharedMemorySize, LDS_BYTES) != hipSuccess) { fprintf(stderr, "kernel_launch: hipFuncSetAttribute failed\n"); grid = -1; return; }
        if (hipOccupancyMaxActiveBlocksPerMultiprocessor(&per_cu, (const void*)mega_fwd, 512, LDS_BYTES) != hipSuccess || per_cu < 1) { fprintf(stderr, "kernel_launch: occupancy query failed (%d)\n", per_cu); per_cu = 1; }
        (void)hipGetLastError();
        grid = cus * per_cu;
    }
    if (grid < 0) return;
    Args a{};
    for (int i = 0; i < 19; ++i) a.in[i] = (const float*)d_in[i];
    a.out = (float*)d_out; a.ws = (unsigned char*)d_ws;
    void* args[] = {&a};
    hipError_t e = hipLaunchCooperativeKernel((const void*)mega_fwd, dim3(grid), dim3(512), args, LDS_BYTES, stream);
    if (e != hipSuccess) fprintf(stderr, "cooperative launch failed: %s (grid %d)\n", hipGetErrorString(e), grid);
}
```
